# Optimizing an MI355X kernel written in HIP

```python
import math
import jax
import jax.numpy as jnp
from jax import lax
import numpy as np

D_MODEL = 1024
BATCH = 8
SEQ = 2048
DEPTH = 2

W_A = 256
A_GROUPS = 4
CHUNK = 128
W_B = 256
CONV_WIDTH = 3
DILATION_PATTERNS = ((128, 1), (512, 4), (2048, 16))
C_GROUPS = 3
C_HEADS_PER_GROUP = 4
C_HEADS = C_GROUPS * C_HEADS_PER_GROUP
C_HEAD_DIM = 64
W_C_QKV = C_HEADS * C_HEAD_DIM
W_C = C_HEADS_PER_GROUP * C_HEAD_DIM
POOL_WINDOWS = (2, 4, 8, 16)
POOL_GROUPS = 4
W_D = 256
D_GROUP = W_D // POOL_GROUPS
N_BRANCH = 4
D_FF = 4 * D_MODEL
N_BUCKETS = 32
MAX_DISTANCE = 2048
EPS = 1e-6

IN_SPLITS = (W_A, W_A, W_B, W_B, W_B, W_C_QKV, W_C_QKV, W_C_QKV, W_D, N_BRANCH * D_MODEL)
D_IN = sum(IN_SPLITS)

kernel_name = "hybrid_gated_parallel_mixers"


def rmsnorm(x, g):
    x32 = x.astype(jnp.float32)
    y = x32 * lax.rsqrt(jnp.mean(jnp.square(x32), axis=-1, keepdims=True) + EPS)
    return y.astype(x.dtype) * g


def layernorm(x, g, b):
    x32 = x.astype(jnp.float32)
    mu = jnp.mean(x32, axis=-1, keepdims=True)
    var = jnp.mean(jnp.square(x32 - mu), axis=-1, keepdims=True)
    return ((x32 - mu) * lax.rsqrt(var + EPS)).astype(x.dtype) * g + b


def gmlp_spatial_gate(u, v, ln_g, ln_b, w_s, b_s):
    B, S, _ = v.shape
    u = jax.nn.gelu(u)
    v = layernorm(jax.nn.gelu(v), ln_g, ln_b)
    vc = v.reshape(B, S // CHUNK, CHUNK, A_GROUPS, W_A // A_GROUPS)
    causal = jnp.tril(jnp.ones((CHUNK, CHUNK), dtype=bool))
    w = jnp.where(causal[None], w_s, jnp.zeros_like(w_s))
    sv = jnp.einsum('gts,bcsgd->bctgd', w, vc) + b_s.T[None, None, :, :, None]
    return u * sv.reshape(B, S, W_A)


def causal_short_conv(z, w):
    S = z.shape[1]
    zp = jnp.pad(z, ((0, 0), (CONV_WIDTH - 1, 0), (0, 0)))
    y = w[0] * zp[:, 0:S]
    for j in range(1, CONV_WIDTH):
        y = y + w[j] * zp[:, j:j + S]
    return y


def t5_causal_bucket(dist):
    max_exact = N_BUCKETS // 2
    d_f = jnp.maximum(dist, 1).astype(jnp.float32)
    large = max_exact + (jnp.log(d_f / max_exact) / math.log(MAX_DISTANCE / max_exact)
                         * (N_BUCKETS - max_exact)).astype(jnp.int32)
    large = jnp.minimum(large, N_BUCKETS - 1)
    return jnp.where(dist < max_exact, dist, large)


def dilated_window_attention(q, k, v, bias_table, window, dil):
    B, S, H, Dh = q.shape
    n = window // dil
    Sp = -(-S // window) * window
    M = Sp // dil
    nb = M // n
    pad = ((0, 0), (0, Sp - S), (0, 0), (0, 0))

    def to_blocks(t):
        return jnp.pad(t, pad).reshape(B, nb, n, dil, H, Dh)

    def with_prev(t):
        prev = jnp.pad(t, ((0, 0), (1, 0), (0, 0), (0, 0), (0, 0), (0, 0)))[:, :nb]
        return jnp.concatenate([prev, t], axis=2)

    qb = to_blocks(q)
    kw = with_prev(to_blocks(k))
    vw = with_prev(to_blocks(v))
    s = jnp.einsum('bnqrhd,bnkrhd->bnrhqk', qb, kw).astype(jnp.float32) * (Dh ** -0.5)

    qi = jnp.arange(n)[:, None]
    ki = jnp.arange(2 * n)[None, :]
    delta = qi + n - ki
    band = (delta >= 0) & (delta <= n)
    blk = jnp.arange(nb)[:, None, None]
    valid = band[None] & ((blk > 0) | (ki >= n)[None])
    bias = bias_table[t5_causal_bucket(jnp.clip(delta, 0, None) * dil)]
    s = s + jnp.transpose(bias, (2, 0, 1)).astype(jnp.float32)[None, None, None]
    s = jnp.where(valid[None, :, None, None], s, -jnp.inf)
    m = jnp.max(s, axis=-1, keepdims=True)
    e = jnp.exp(s - m)
    den = jnp.sum(e, axis=-1, keepdims=True)
    o = jnp.einsum('bnrhqk,bnkrhd->bnqrhd', (e / den).astype(v.dtype), vw)
    lse = (m + jnp.log(den))[..., 0]
    o = o.reshape(B, Sp, H, Dh)[:, :S]
    lse = jnp.transpose(lse, (0, 1, 4, 2, 3)).reshape(B, Sp, H)[:, :S]
    return o, lse


def dilated_mixture(q, k, v, rel_bias):
    B, S, _ = q.shape
    shp = (B, S, C_GROUPS, C_HEADS_PER_GROUP, C_HEAD_DIM)
    q, k, v = q.reshape(shp), k.reshape(shp), v.reshape(shp)
    outs, lses = [], []
    for g, (window, dil) in enumerate(DILATION_PATTERNS):
        hs = slice(g * C_HEADS_PER_GROUP, (g + 1) * C_HEADS_PER_GROUP)
        o, lse = dilated_window_attention(q[:, :, g], k[:, :, g], v[:, :, g],
                                          rel_bias[:, hs], window, dil)
        outs.append(o)
        lses.append(lse)
    o = jnp.stack(outs, axis=2)
    alpha = jax.nn.softmax(jnp.stack(lses, axis=2), axis=2)
    out = jnp.einsum('bsgh,bsghd->bshd', alpha.astype(o.dtype), o)
    return out.reshape(B, S, W_C)


def multiscale_pool(z, w_pool, scale):
    B, S, _ = z.shape
    zg = z.reshape(B, S, POOL_GROUPS, D_GROUP).astype(jnp.float32)
    t = jnp.arange(S, dtype=jnp.float32)
    outs = []
    for gi, w in enumerate(POOL_WINDOWS):
        c = jnp.cumsum(zg[:, :, gi], axis=1)
        c_lag = jnp.pad(c, ((0, 0), (w, 0), (0, 0)))[:, :S]
        cnt = jnp.minimum(t + 1.0, float(w))
        outs.append((c - c_lag) / cnt[None, :, None])
    pooled = jnp.stack(outs, axis=2)
    y = (pooled - zg).astype(z.dtype)
    y = jnp.einsum('bsgd,gde->bsge', y, w_pool).reshape(B, S, W_D)
    return y * scale


def setup_inputs(seed: int = 0) -> dict:
    key = jax.random.key(seed)
    ks = jax.random.split(key, 21)
    L = DEPTH

    def nrm(k, shape, scale):
        return jax.random.normal(k, shape, jnp.float32) * scale

    return {
        "x": nrm(ks[0], (BATCH, SEQ, D_MODEL), 1.0),
        "norm_mix_g": 1.0 + nrm(ks[1], (L, D_MODEL), 0.05),
        "w_in": nrm(ks[2], (L, D_MODEL, D_IN), D_MODEL ** -0.5),
        "a_ln_g": 1.0 + nrm(ks[3], (L, W_A), 0.05),
        "a_ln_b": nrm(ks[4], (L, W_A), 0.02),
        "a_ws": nrm(ks[5], (L, A_GROUPS, CHUNK, CHUNK), CHUNK ** -0.5),
        "a_bs": 1.0 + nrm(ks[6], (L, A_GROUPS, CHUNK), 0.1),
        "w_a_out": nrm(ks[7], (L, W_A, D_MODEL), W_A ** -0.5),
        "b_conv": nrm(ks[8], (L, CONV_WIDTH, W_B), CONV_WIDTH ** -0.5),
        "w_b_out": nrm(ks[9], (L, W_B, D_MODEL), W_B ** -0.5),
        "rel_bias": nrm(ks[10], (N_BUCKETS, C_HEADS), 0.5),
        "w_c_out": nrm(ks[11], (L, W_C, D_MODEL), W_C ** -0.5),
        "d_w": nrm(ks[12], (L, POOL_GROUPS, D_GROUP, D_GROUP), D_GROUP ** -0.5),
        "d_scale": 1.0 + nrm(ks[13], (L, W_D), 0.1),
        "w_d_out": nrm(ks[14], (L, W_D, D_MODEL), W_D ** -0.5),
        "w_o": nrm(ks[15], (L, D_MODEL, D_MODEL), D_MODEL ** -0.5),
        "norm_ff_g": 1.0 + nrm(ks[16], (L, D_MODEL), 0.05),
        "w_ff1": nrm(ks[17], (L, D_MODEL, D_FF), D_MODEL ** -0.5),
        "w_ff2": nrm(ks[18], (L, D_FF, D_MODEL), D_FF ** -0.5),
        "final_g": 1.0 + nrm(ks[19], (D_MODEL,), 0.05),
    }


def reference(x, norm_mix_g, w_in, a_ln_g, a_ln_b, a_ws, a_bs, w_a_out, b_conv, w_b_out,
              rel_bias, w_c_out, d_w, d_scale, w_d_out, w_o, norm_ff_g, w_ff1, w_ff2, final_g):
    B, S, _ = x.shape
    split_at = [sum(IN_SPLITS[:i + 1]) for i in range(len(IN_SPLITS) - 1)]
    for l in range(DEPTH):
        h = rmsnorm(x, norm_mix_g[l])
        z = h @ w_in[l]
        a_u, a_v, b_b, b_c, b_x, c_q, c_k, c_v, d_z, gates = jnp.split(z, split_at, axis=-1)

        y_a = gmlp_spatial_gate(a_u, a_v, a_ln_g[l], a_ln_b[l], a_ws[l], a_bs[l]) @ w_a_out[l]
        y_b = (b_b * causal_short_conv(b_c * b_x, b_conv[l])) @ w_b_out[l]
        y_c = dilated_mixture(c_q, c_k, c_v, rel_bias) @ w_c_out[l]
        y_d = multiscale_pool(d_z, d_w[l], d_scale[l]) @ w_d_out[l]

        g = jax.nn.sigmoid(gates).reshape(B, S, N_BRANCH, D_MODEL)
        merged = (g[:, :, 0] * y_a + g[:, :, 1] * y_b
                  + g[:, :, 2] * y_c + g[:, :, 3] * y_d)
        x = x + merged @ w_o[l]

        h2 = rmsnorm(x, norm_ff_g[l])
        x = x + jnp.square(jax.nn.relu(h2 @ w_ff1[l])) @ w_ff2[l]
    return rmsnorm(x, final_g)
```

```cpp
#include <hip/hip_runtime.h>
#include <stdint.h>
#include <stdio.h>

typedef unsigned short bf16_t;
typedef short bf16x8 __attribute__((ext_vector_type(8)));
typedef float f32x4 __attribute__((ext_vector_type(4)));
typedef unsigned u32x4 __attribute__((ext_vector_type(4)));
typedef unsigned u32x2 __attribute__((ext_vector_type(2)));

namespace C {
constexpr int D = 1024, NB = 8, S = 2048, T = NB * S, L = 2;
constexpr int DIN = 7936, DFF = 4096;
constexpr float EPS = 1e-6f;
constexpr size_t MiB = 1u << 20;
constexpr size_t WS_CTL = 0;
constexpr size_t WS_SSQ = 1 * MiB;
constexpr size_t WS_WIN = 3 * MiB;
constexpr size_t WS_WOUT = WS_WIN + 15 * MiB + MiB / 2;
constexpr size_t WS_WO = WS_WOUT + 2 * MiB;
constexpr size_t WS_W1 = WS_WO + 2 * MiB;
constexpr size_t WS_W2 = WS_W1 + 8 * MiB;
constexpr size_t WS_XB = 40 * MiB;
constexpr size_t WS_ZA = 72 * MiB;
constexpr size_t WS_ZB = 88 * MiB;
constexpr size_t WS_ZQKV = 112 * MiB;
constexpr size_t WS_ZD = 184 * MiB;
constexpr size_t WS_G = 192 * MiB;
constexpr size_t WS_MERGED = 72 * MiB;
constexpr size_t WS_H = 112 * MiB;
constexpr size_t WS_END = 256 * MiB;
}

__device__ __forceinline__ float bf2f(bf16_t v) { return __uint_as_float((unsigned)v << 16); }
__device__ __forceinline__ unsigned f2bf(float f) { unsigned u = __float_as_uint(f); return (u + 0x7fffu + ((u >> 16) & 1u)) >> 16; }
__device__ __forceinline__ unsigned pk2(float lo, float hi) { return f2bf(lo) | (f2bf(hi) << 16); }
__device__ __forceinline__ float sigmoidf_(float x) { return 1.0f / (1.0f + __expf(-x)); }
__device__ __forceinline__ float gelu_tanh(float x) { const float u = 0.7978845608028654f * (x + 0.044715f * x * x * x); return x * sigmoidf_(2.0f * u); }
__device__ __forceinline__ float wave_sum(float v) {
#pragma unroll
    for (int o = 1; o < 64; o <<= 1) v += __shfl_xor(v, o);
    return v;
}
__device__ __forceinline__ int t5_bucket(int dist) {
    if (dist < 16) return dist;
    int k = 16;
    k += dist >= 22; k += dist >= 30; k += dist >= 40; k += dist >= 54; k += dist >= 73; k += dist >= 99; k += dist >= 134; k += dist >= 182;
    k += dist >= 246; k += dist >= 332; k += dist >= 450; k += dist >= 609; k += dist >= 825; k += dist >= 1117; k += dist >= 1513;
    return k;
}

__global__ __launch_bounds__(256) void k_prologue(const float* __restrict__ x, float* __restrict__ X, bf16_t* __restrict__ XB, float* __restrict__ SSQ) {
    const int lane = threadIdx.x & 63, gw = (blockIdx.x * blockDim.x + threadIdx.x) >> 6, ngw = (gridDim.x * blockDim.x) >> 6;
    for (int row = gw; row < C::T; row += ngw) {
        const f32x4* xr = (const f32x4*)(x + (size_t)row * C::D) + lane;
        f32x4* Xr = (f32x4*)(X + (size_t)row * C::D) + lane;
        u32x2* br = (u32x2*)(XB + (size_t)row * C::D) + lane;
        float s = 0.f;
#pragma unroll
        for (int j = 0; j < 4; ++j) { const f32x4 v = xr[64 * j]; s += (v.x * v.x + v.y * v.y) + (v.z * v.z + v.w * v.w); Xr[64 * j] = v; u32x2 w; w.x = pk2(v.x, v.y); w.y = pk2(v.z, v.w); br[64 * j] = w; }
        s = wave_sum(s);
        if (lane == 0) { f32x4 o = {s, 0.f, 0.f, 0.f}; *(f32x4*)(SSQ + (size_t)row * 4) = o; }
    }
}
__global__ __launch_bounds__(256) void k_rowstats(const float* __restrict__ X, float* __restrict__ SSQ) {
    const int lane = threadIdx.x & 63, gw = (blockIdx.x * blockDim.x + threadIdx.x) >> 6, ngw = (gridDim.x * blockDim.x) >> 6;
    for (int row = gw; row < C::T; row += ngw) {
        const f32x4* xr = (const f32x4*)(X + (size_t)row * C::D) + lane;
        float s = 0.f;
#pragma unroll
        for (int j = 0; j < 4; ++j) { const f32x4 v = xr[64 * j]; s += (v.x * v.x + v.y * v.y) + (v.z * v.z + v.w * v.w); }
        s = wave_sum(s);
        if (lane == 0) { f32x4 o = {s, 0.f, 0.f, 0.f}; *(f32x4*)(SSQ + (size_t)row * 4) = o; }
    }
}
__global__ __launch_bounds__(256) void k_final(float* __restrict__ X, const float* __restrict__ g) {
    const int lane = threadIdx.x & 63, gw = (blockIdx.x * blockDim.x + threadIdx.x) >> 6, ngw = (gridDim.x * blockDim.x) >> 6;
    for (int row = gw; row < C::T; row += ngw) {
        f32x4* xr = (f32x4*)(X + (size_t)row * C::D) + lane;
        const f32x4* gr = (const f32x4*)g + lane;
        f32x4 v[4]; float s = 0.f;
#pragma unroll
        for (int j = 0; j < 4; ++j) { v[j] = xr[64 * j]; s += (v[j].x * v[j].x + v[j].y * v[j].y) + (v[j].z * v[j].z + v[j].w * v[j].w); }
        s = wave_sum(s);
        const float rstd = rsqrtf(s * (1.0f / C::D) + C::EPS);
#pragma unroll
        for (int j = 0; j < 4; ++j) { const f32x4 gg = gr[64 * j]; f32x4 o; o.x = v[j].x * rstd * gg.x; o.y = v[j].y * rstd * gg.y; o.z = v[j].z * rstd * gg.z; o.w = v[j].w * rstd * gg.w; xr[64 * j] = o; }
    }
}

__device__ __forceinline__ void transpose_item(const float* __restrict__ W, int K, int N, bf16_t* __restrict__ WT, int ldd, int koff, const float* __restrict__ scale, float* scr, int item, int lane) {
    const int nblk = N / 32, kb = item / nblk, nb = item % nblk, k0 = 64 * kb, n0 = 32 * nb;
#pragma unroll 8
    for (int i = 0; i < 32; ++i) { const int kk = 2 * i + (lane >> 5); const float sc = scale ? scale[k0 + kk] : 1.0f; scr[kk * 33 + (lane & 31)] = W[(size_t)(k0 + kk) * N + n0 + (lane & 31)] * sc; }
    __builtin_amdgcn_s_waitcnt(0xC07F); asm volatile("" ::: "memory");
    const int c = lane & 7;
#pragma unroll
    for (int j = 0; j < 4; ++j) { const int n = (lane >> 3) + 8 * j; const float* s = scr + (8 * c) * 33 + n;
        u32x4 o; o.x = pk2(s[0 * 33], s[1 * 33]); o.y = pk2(s[2 * 33], s[3 * 33]); o.z = pk2(s[4 * 33], s[5 * 33]); o.w = pk2(s[6 * 33], s[7 * 33]);
        *(u32x4*)(WT + (size_t)(n0 + n) * ldd + koff + k0 + 8 * c) = o; }
    __builtin_amdgcn_s_waitcnt(0xC07F); asm volatile("" ::: "memory");
}
struct ConvArgs { const float *w_in, *g_mix, *w_a, *w_b, *w_c, *w_d, *d_scale, *w_o, *w_ff1, *g_ff, *w_ff2; bf16_t *WinT, *WoutT, *WoT, *W1T, *W2T; };
__global__ __launch_bounds__(256) void k_convert(ConvArgs a) {
    __shared__ float scr_all[4][64 * 33];
    const int lane = threadIdx.x & 63, wv = threadIdx.x >> 6;
    float* scr = scr_all[wv];
    const int gw = blockIdx.x * 4 + wv, ngw = gridDim.x * 4;
    constexpr int I_IN = (C::D / 64) * (C::DIN / 32), I_OUT = (256 / 64) * (C::D / 32), I_O = (C::D / 64) * (C::D / 32), I_1 = (C::D / 64) * (C::DFF / 32), I_2 = (C::DFF / 64) * (C::D / 32);
    constexpr int NITEMS = I_IN + 4 * I_OUT + I_O + I_1 + I_2;
    for (int it = gw; it < NITEMS; it += ngw) {
        int r = it;
        if (r < I_IN) { transpose_item(a.w_in, C::D, C::DIN, a.WinT, C::D, 0, a.g_mix, scr, r, lane); continue; } r -= I_IN;
        if (r < I_OUT) { transpose_item(a.w_a, 256, C::D, a.WoutT, C::D, 0, nullptr, scr, r, lane); continue; } r -= I_OUT;
        if (r < I_OUT) { transpose_item(a.w_b, 256, C::D, a.WoutT, C::D, 256, nullptr, scr, r, lane); continue; } r -= I_OUT;
        if (r < I_OUT) { transpose_item(a.w_c, 256, C::D, a.WoutT, C::D, 512, nullptr, scr, r, lane); continue; } r -= I_OUT;
        if (r < I_OUT) { transpose_item(a.w_d, 256, C::D, a.WoutT, C::D, 768, a.d_scale, scr, r, lane); continue; } r -= I_OUT;
        if (r < I_O) { transpose_item(a.w_o, C::D, C::D, a.WoT, C::D, 0, nullptr, scr, r, lane); continue; } r -= I_O;
        if (r < I_1) { transpose_item(a.w_ff1, C::D, C::DFF, a.W1T, C::D, 0, a.g_ff, scr, r, lane); continue; } r -= I_1;
        transpose_item(a.w_ff2, C::DFF, C::D, a.W2T, C::DFF, 0, nullptr, scr, r, lane);
    }
}

__device__ __forceinline__ float row_rstd(const float* SSQ, int row) { const f32x4 s = *(const f32x4*)(SSQ + (size_t)row * 4); return rsqrtf(((s.x + s.y) + (s.z + s.w)) * (1.0f / C::D) + C::EPS); }

struct EpiInproj {
    const float* SSQ; bf16_t *za, *zb, *zqkv, *zd; unsigned char* g;
    __device__ __forceinline__ void operator()(int row, int col, float acc) const {
        const float v = acc * row_rstd(SSQ, row);
        if (col < 512) za[(size_t)row * 512 + col] = (bf16_t)f2bf(gelu_tanh(v));
        else if (col < 1280) zb[(size_t)row * 768 + (col - 512)] = (bf16_t)f2bf(v);
        else if (col < 3584) zqkv[(size_t)row * 2304 + (col - 1280)] = (bf16_t)f2bf(v);
        else if (col < 3840) zd[(size_t)row * 256 + (col - 3584)] = (bf16_t)f2bf(v);
        else g[(size_t)row * 4096 + (col - 3840)] = (unsigned char)(sigmoidf_(v) * 255.0f + 0.5f);
    }
};
struct EpiResid {
    float* X; bf16_t* XB;
    __device__ __forceinline__ void operator()(int row, int col, float acc) const {
        const size_t i = (size_t)row * C::D + col; const float xn = X[i] + acc; X[i] = xn; XB[i] = (bf16_t)f2bf(xn);
    }
};
struct EpiFF1 {
    const float* SSQ; bf16_t* H;
    __device__ __forceinline__ void operator()(int row, int col, float acc) const {
        const float v = fmaxf(acc * row_rstd(SSQ, row), 0.f); H[(size_t)row * C::DFF + col] = (bf16_t)f2bf(v * v);
    }
};

template <class Epi>
__global__ __launch_bounds__(256) void k_gemm_naive(const bf16_t* __restrict__ A, int lda, const bf16_t* __restrict__ Bt, int ldb, int K, Epi E) {
    const int lane = threadIdx.x & 63, wv = threadIdx.x >> 6, fr = lane & 15, fq = lane >> 4;
    const int m0 = blockIdx.y * 128 + (wv >> 1) * 64, n0 = blockIdx.x * 128 + (wv & 1) * 64;
    f32x4 acc[4][4];
#pragma unroll
    for (int i = 0; i < 4; ++i)
#pragma unroll
        for (int j = 0; j < 4; ++j) acc[i][j] = (f32x4){0.f, 0.f, 0.f, 0.f};
    const bf16_t* ap = A + (size_t)(m0 + fr) * lda + fq * 8;
    const bf16_t* bp = Bt + (size_t)(n0 + fr) * ldb + fq * 8;
    for (int k0 = 0; k0 < K; k0 += 32) {
        bf16x8 a[4], b[4];
#pragma unroll
        for (int i = 0; i < 4; ++i) { a[i] = *(const bf16x8*)(ap + (size_t)(i * 16) * lda + k0); b[i] = *(const bf16x8*)(bp + (size_t)(i * 16) * ldb + k0); }
#pragma unroll
        for (int i = 0; i < 4; ++i)
#pragma unroll
            for (int j = 0; j < 4; ++j) acc[i][j] = __builtin_amdgcn_mfma_f32_16x16x32_bf16(a[i], b[j], acc[i][j], 0, 0, 0);
    }
#pragma unroll
    for (int i = 0; i < 4; ++i)
#pragma unroll
        for (int j = 0; j < 4; ++j)
#pragma unroll
            for (int r = 0; r < 4; ++r) E(m0 + i * 16 + fq * 4 + r, n0 + j * 16 + fr, acc[i][j][r]);
}
__global__ __launch_bounds__(256) void k_merge_naive(const bf16_t* __restrict__ A, const bf16_t* __restrict__ Bt, const unsigned char* __restrict__ G, bf16_t* __restrict__ O) {
    const int lane = threadIdx.x & 63, wv = threadIdx.x >> 6, fr = lane & 15, fq = lane >> 4;
    const int m0 = blockIdx.y * 128 + (wv >> 1) * 64, n0 = blockIdx.x * 128 + (wv & 1) * 64;
    f32x4 tot[4][4];
#pragma unroll
    for (int i = 0; i < 4; ++i)
#pragma unroll
        for (int j = 0; j < 4; ++j) tot[i][j] = (f32x4){0.f, 0.f, 0.f, 0.f};
    const bf16_t* ap = A + (size_t)(m0 + fr) * C::D + fq * 8;
    const bf16_t* bp = Bt + (size_t)(n0 + fr) * C::D + fq * 8;
    for (int seg = 0; seg < 4; ++seg) {
        f32x4 acc[4][4];
#pragma unroll
        for (int i = 0; i < 4; ++i)
#pragma unroll
            for (int j = 0; j < 4; ++j) acc[i][j] = (f32x4){0.f, 0.f, 0.f, 0.f};
        for (int k0 = seg * 256; k0 < seg * 256 + 256; k0 += 32) {
            bf16x8 a[4], b[4];
#pragma unroll
            for (int i = 0; i < 4; ++i) { a[i] = *(const bf16x8*)(ap + (size_t)(i * 16) * C::D + k0); b[i] = *(const bf16x8*)(bp + (size_t)(i * 16) * C::D + k0); }
#pragma unroll
            for (int i = 0; i < 4; ++i)
#pragma unroll
                for (int j = 0; j < 4; ++j) acc[i][j] = __builtin_amdgcn_mfma_f32_16x16x32_bf16(a[i], b[j], acc[i][j], 0, 0, 0);
        }
#pragma unroll
        for (int i = 0; i < 4; ++i)
#pragma unroll
            for (int j = 0; j < 4; ++j)
#pragma unroll
                for (int r = 0; r < 4; ++r) { const int row = m0 + i * 16 + fq * 4 + r, col = n0 + j * 16 + fr; tot[i][j][r] += (float)G[(size_t)row * 4096 + seg * 1024 + col] * (1.0f / 255.0f) * acc[i][j][r]; }
    }
#pragma unroll
    for (int i = 0; i < 4; ++i)
#pragma unroll
        for (int j = 0; j < 4; ++j)
#pragma unroll
            for (int r = 0; r < 4; ++r) { const int row = m0 + i * 16 + fq * 4 + r, col = n0 + j * 16 + fr; O[(size_t)row * C::D + col] = (bf16_t)f2bf(tot[i][j][r]); }
}

__global__ __launch_bounds__(256) void k_mixA_naive(const bf16_t* __restrict__ ZA, const float* __restrict__ ln_g, const float* __restrict__ ln_b, const float* __restrict__ ws, const float* __restrict__ bs, bf16_t* __restrict__ MIX) {
    __shared__ float mu[128], rs[128];
    const int t0 = blockIdx.x * 128, lane = threadIdx.x & 63, wv = threadIdx.x >> 6, ch = threadIdx.x;
    for (int i = 0; i < 32; ++i) {
        const int ti = wv * 32 + i; const bf16_t* p = ZA + (size_t)(t0 + ti) * 512 + 256 + lane * 4;
        const float a = bf2f(p[0]), b = bf2f(p[1]), c = bf2f(p[2]), d = bf2f(p[3]);
        const float m = wave_sum((a + b) + (c + d)) * (1.0f / 256.0f);
        const float va = wave_sum(((a - m) * (a - m) + (b - m) * (b - m)) + ((c - m) * (c - m) + (d - m) * (d - m))) * (1.0f / 256.0f);
        if (lane == 0) { mu[ti] = m; rs[ti] = rsqrtf(va + C::EPS); }
    }
    __syncthreads();
    const int g = ch >> 6; const float lg = ln_g[ch], lb = ln_b[ch];
    for (int ti = 0; ti < 128; ++ti) {
        float acc = 0.f; const float* wrow = ws + ((size_t)g * 128 + ti) * 128;
        for (int si = 0; si <= ti; ++si) { const float vln = (bf2f(ZA[(size_t)(t0 + si) * 512 + 256 + ch]) - mu[si]) * rs[si] * lg + lb; acc += wrow[si] * vln; }
        const float sv = acc + bs[g * 128 + ti];
        MIX[(size_t)(t0 + ti) * C::D + ch] = (bf16_t)f2bf(bf2f(ZA[(size_t)(t0 + ti) * 512 + ch]) * sv);
    }
}
__global__ __launch_bounds__(256) void k_mixB_naive(const bf16_t* __restrict__ ZB, const float* __restrict__ cw, bf16_t* __restrict__ MIX) {
    const int idx = blockIdx.x * 256 + threadIdx.x, t = idx >> 8, ch = idx & 255, s = t & (C::S - 1);
    float acc = 0.f;
#pragma unroll
    for (int j = 0; j < 3; ++j) { const int ss = s + j - 2; if (ss >= 0) { const bf16_t* p = ZB + (size_t)(t + j - 2) * 768; acc += cw[j * 256 + ch] * (bf2f(p[256 + ch]) * bf2f(p[512 + ch])); } }
    MIX[(size_t)t * C::D + 256 + ch] = (bf16_t)f2bf(bf2f(ZB[(size_t)t * 768 + ch]) * acc);
}
__global__ __launch_bounds__(256) void k_attn_naive(const bf16_t* __restrict__ Z, const float* __restrict__ rel_bias, bf16_t* __restrict__ MIX) {
    const int lane = threadIdx.x & 63, gw = (blockIdx.x * 256 + threadIdx.x) >> 6;
    const int t = gw >> 2, hh = gw & 3, s = t & (C::S - 1), b0 = t - s;
    float og[3], lse[3];
#pragma unroll
    for (int g = 0; g < 3; ++g) {
        const int dil = g == 0 ? 1 : (g == 1 ? 4 : 16), head = g * 4 + hh, colq = g * 256 + hh * 64 + lane;
        const float q = bf2f(Z[(size_t)t * 2304 + colq]);
        const int midx = s / dil, nk = (midx < 128 ? midx : 128) + 1;
        float m = -INFINITY, l = 0.f, o = 0.f;
        for (int dl = 0; dl < nk; ++dl) {
            const size_t kr = (size_t)(b0 + s - dl * dil) * 2304;
            const float kd = bf2f(Z[kr + 768 + colq]), vd = bf2f(Z[kr + 1536 + colq]);
            const float sc = wave_sum(q * kd) * 0.125f + rel_bias[t5_bucket(dl * dil) * 12 + head];
            const float mn = fmaxf(m, sc), f = __expf(m - mn), p = __expf(sc - mn);
            l = l * f + p; o = o * f + p * vd; m = mn;
        }
        og[g] = o / l; lse[g] = m + __logf(l);
    }
    const float mx = fmaxf(fmaxf(lse[0], lse[1]), lse[2]);
    const float w0 = __expf(lse[0] - mx), w1 = __expf(lse[1] - mx), w2 = __expf(lse[2] - mx);
    MIX[(size_t)t * C::D + 512 + hh * 64 + lane] = (bf16_t)f2bf((w0 * og[0] + w1 * og[1] + w2 * og[2]) / (w0 + w1 + w2));
}
__global__ __launch_bounds__(256) void k_mixD_naive(const bf16_t* __restrict__ ZD, const float* __restrict__ dw, bf16_t* __restrict__ MIX) {
    const int idx = blockIdx.x * 256 + threadIdx.x, t = idx >> 8, c = idx & 255, gi = c >> 6, e = c & 63, s = t & (C::S - 1);
    const int w = 2 << gi, cnt = (s + 1 < w) ? s + 1 : w; const float inv = 1.0f / (float)cnt;
    float acc = 0.f;
    for (int d = 0; d < 64; ++d) {
        float sum = 0.f;
        for (int j = 0; j < cnt; ++j) sum += bf2f(ZD[(size_t)(t - j) * 256 + gi * 64 + d]);
        const float y = sum * inv - bf2f(ZD[(size_t)t * 256 + gi * 64 + d]);
        acc += y * dw[((size_t)gi * 64 + d) * 64 + e];
    }
    MIX[(size_t)t * C::D + 768 + c] = (bf16_t)f2bf(acc);
}

extern "C" void kernel_launch(void* const* d_in, const int* in_sizes, int n_in, void* d_out, int out_size, void* d_ws, size_t ws_size, hipStream_t stream) {
    using namespace C;
    if (n_in != 20 || out_size != T * D || ws_size < WS_END) { fprintf(stderr, "kernel_launch: unexpected shapes (n_in %d out %d ws %zu)\n", n_in, out_size, ws_size); return; }
    const float* x = (const float*)d_in[0]; const float* norm_mix_g = (const float*)d_in[1]; const float* w_in = (const float*)d_in[2];
    const float* a_ln_g = (const float*)d_in[3]; const float* a_ln_b = (const float*)d_in[4]; const float* a_ws = (const float*)d_in[5]; const float* a_bs = (const float*)d_in[6];
    const float* w_a_out = (const float*)d_in[7]; const float* b_conv = (const float*)d_in[8]; const float* w_b_out = (const float*)d_in[9]; const float* rel_bias = (const float*)d_in[10];
    const float* w_c_out = (const float*)d_in[11]; const float* d_w = (const float*)d_in[12]; const float* d_scale = (const float*)d_in[13]; const float* w_d_out = (const float*)d_in[14];
    const float* w_o = (const float*)d_in[15]; const float* norm_ff_g = (const float*)d_in[16]; const float* w_ff1 = (const float*)d_in[17]; const float* w_ff2 = (const float*)d_in[18]; const float* final_g = (const float*)d_in[19];
    unsigned char* ws = (unsigned char*)d_ws; float* X = (float*)d_out;
    float* SSQ = (float*)(ws + WS_SSQ);
    bf16_t *WinT = (bf16_t*)(ws + WS_WIN), *WoutT = (bf16_t*)(ws + WS_WOUT), *WoT = (bf16_t*)(ws + WS_WO), *W1T = (bf16_t*)(ws + WS_W1), *W2T = (bf16_t*)(ws + WS_W2);
    bf16_t *XB = (bf16_t*)(ws + WS_XB), *MIX = XB, *ZA = (bf16_t*)(ws + WS_ZA), *ZB = (bf16_t*)(ws + WS_ZB), *ZQKV = (bf16_t*)(ws + WS_ZQKV), *ZD = (bf16_t*)(ws + WS_ZD);
    unsigned char* G = ws + WS_G; bf16_t *MERGED = (bf16_t*)(ws + WS_MERGED), *H = (bf16_t*)(ws + WS_H);

    k_prologue<<<1024, 256, 0, stream>>>(x, X, XB, SSQ);
    for (int l = 0; l < L; ++l) {
        ConvArgs ca{w_in + (size_t)l * D * DIN, norm_mix_g + l * D, w_a_out + (size_t)l * 256 * D, w_b_out + (size_t)l * 256 * D, w_c_out + (size_t)l * 256 * D, w_d_out + (size_t)l * 256 * D, d_scale + l * 256,
                    w_o + (size_t)l * D * D, w_ff1 + (size_t)l * D * DFF, norm_ff_g + l * D, w_ff2 + (size_t)l * DFF * D, WinT, WoutT, WoT, W1T, W2T};
        k_convert<<<1024, 256, 0, stream>>>(ca);
        k_gemm_naive<EpiInproj><<<dim3(DIN / 128, T / 128), 256, 0, stream>>>(XB, D, WinT, D, D, EpiInproj{SSQ, ZA, ZB, ZQKV, ZD, G});
        k_mixA_naive<<<T / 128, 256, 0, stream>>>(ZA, a_ln_g + l * 256, a_ln_b + l * 256, a_ws + (size_t)l * 4 * 128 * 128, a_bs + l * 4 * 128, MIX);
        k_mixB_naive<<<T, 256, 0, stream>>>(ZB, b_conv + l * 3 * 256, MIX);
        k_attn_naive<<<T, 256, 0, stream>>>(ZQKV, rel_bias, MIX);
        k_mixD_naive<<<T, 256, 0, stream>>>(ZD, d_w + (size_t)l * 4 * 64 * 64, MIX);
        k_merge_naive<<<dim3(D / 128, T / 128), 256, 0, stream>>>(MIX, WoutT, G, MERGED);
        k_gemm_naive<EpiResid><<<dim3(D / 128, T / 128), 256, 0, stream>>>(MERGED, D, WoT, D, D, EpiResid{X, XB});
        k_rowstats<<<1024, 256, 0, stream>>>(X, SSQ);
        k_gemm_naive<EpiFF1><<<dim3(DFF / 128, T / 128), 256, 0, stream>>>(XB, D, W1T, D, D, EpiFF1{SSQ, H});
        k_gemm_naive<EpiResid><<<dim3(D / 128, T / 128), 256, 0, stream>>>(H, DFF, W2T, DFF, DFF, EpiResid{X, XB});
        k_rowstats<<<1024, 256, 0, stream>>>(X, SSQ);
    }
    k_final<<<1024, 256, 0, stream>>>(X, final_g);
}
```

```cpp
#include <hip/hip_runtime.h>
#include <stdint.h>
#include <stdio.h>

namespace C {
constexpr int D = 1024, NB = 8, S = 2048, T = NB * S, L = 2;
constexpr int DIN = 7936, DFF = 4096;
constexpr float EPS = 1e-6f;
constexpr size_t MiB = 1u << 20;
constexpr size_t WS_CTL = 0, CTL_ZERO_BYTES = 256 * 1024;
constexpr size_t WS_SSQ = 1 * MiB;
constexpr size_t WS_WSB = 2 * MiB;
constexpr size_t WS_WSUM = 2 * MiB + 196608;
constexpr size_t WS_DWT = 2 * MiB + 131072;
constexpr size_t WS_WIN = 3 * MiB;
constexpr size_t WS_WOUT = WS_WIN + 15 * MiB + MiB / 2;
constexpr size_t WS_WO = WS_WOUT + 2 * MiB;
constexpr size_t WS_W1 = WS_WO + 2 * MiB;
constexpr size_t WS_W2 = WS_W1 + 8 * MiB;
constexpr size_t WS_XB = 40 * MiB;
constexpr size_t WS_ZA = 72 * MiB;
constexpr size_t WS_ZB = 88 * MiB;
constexpr size_t WS_ZQKV = 112 * MiB;
constexpr size_t WS_ZD = 184 * MiB;
constexpr size_t WS_G = 192 * MiB;
constexpr size_t WS_MERGED = 72 * MiB;
constexpr size_t WS_PART = 112 * MiB;
constexpr size_t WS_H = 112 * MiB;
constexpr size_t WS_END = 256 * MiB;
constexpr int CW_PANEL = 32768;
constexpr int CW_GMAX = 2048;
constexpr int I8_N0 = 1280;
constexpr size_t OUT_W2T1 = 32 * MiB, OUT_XQ = 40 * MiB, OUT_WGQ = 56 * MiB, OUT_WSC = 56 * MiB + (size_t)7936 * 1024;
constexpr int CW_BAR = 4096;
constexpr int RING_BYTES = 131072, LDSCTL_OFF = RING_BYTES, MISC_OFF = LDSCTL_OFF + 320, RTAB_OFF = RING_BYTES + 1024  , CTAB_OFF = RING_BYTES + 2048  , XTAB_OFF = CTAB_OFF + 8192  , LDS_BYTES = CTAB_OFF + 16384;
}
#define LAS __attribute__((address_space(3)))
#define GAS __attribute__((address_space(1)))
__device__ __forceinline__ float bf2f(unsigned short v) { return __uint_as_float((unsigned)v << 16); }
__device__ __forceinline__ unsigned f2bf(float f) { unsigned u = __float_as_uint(f); return (u + 0x7fffu + ((u >> 16) & 1u)) >> 16; }
typedef float f32x2_t_ __attribute__((ext_vector_type(2))); typedef __bf16 bf16x2_t_ __attribute__((ext_vector_type(2)));
__device__ __forceinline__ unsigned pk2(float lo, float hi) { const f32x2_t_ v = {lo, hi}; const bf16x2_t_ b = __builtin_convertvector(v, bf16x2_t_); return __builtin_bit_cast(unsigned, b); }
__device__ __forceinline__ float sigmoidf_(float x) { return __builtin_amdgcn_rcpf(1.0f + __builtin_amdgcn_exp2f(-1.4426950408889634f * x)); }
__device__ __forceinline__ float gelu_tanh(float x) { const float u = 0.7978845608028654f * (x + 0.044715f * x * x * x); return x * sigmoidf_(2.0f * u); }
template <int X> __device__ __forceinline__ float swz_xor(float v) { return __int_as_float(__builtin_amdgcn_ds_swizzle(__float_as_int(v), 0x1F | (X << 10))); }
__device__ __forceinline__ float half_sum(float v) { const auto r = __builtin_amdgcn_permlane32_swap(__float_as_uint(v), __float_as_uint(v), false, false); return __uint_as_float(r[0]) + __uint_as_float(r[1]); }
__device__ __forceinline__ float half_max(float v) { const auto r = __builtin_amdgcn_permlane32_swap(__float_as_uint(v), __float_as_uint(v), false, false); return fmaxf(__uint_as_float(r[0]), __uint_as_float(r[1])); }
__device__ __forceinline__ float wave_sum(float v) { v += swz_xor<1>(v); v += swz_xor<2>(v); v += swz_xor<4>(v); v += swz_xor<8>(v); v += swz_xor<16>(v); return half_sum(v); }
__device__ __forceinline__ int t5_bucket(int dist) {
    if (dist < 16) return dist;
    int k = 16;
    k += dist >= 22; k += dist >= 30; k += dist >= 40; k += dist >= 54; k += dist >= 73; k += dist >= 99; k += dist >= 134; k += dist >= 182;
    k += dist >= 246; k += dist >= 332; k += dist >= 450; k += dist >= 609; k += dist >= 825; k += dist >= 1117; k += dist >= 1513;
    return k;
}
__device__ __forceinline__ float row_rstd16(const float* SSQ, int row) {
    typedef float f4 __attribute__((ext_vector_type(4)));
    const f4* p = (const f4*)(SSQ + (size_t)row * 16); const f4 a = p[0], b = p[1], c = p[2], d = p[3];
    const float s = ((a.x + a.y) + (a.z + a.w)) + ((b.x + b.y) + (b.z + b.w)) + ((c.x + c.y) + (c.z + c.w)) + ((d.x + d.y) + (d.z + d.w));
    return rsqrtf(s * (1.0f / C::D) + C::EPS);
}
namespace pg8 {
#define PG8_LAS __attribute__((address_space(3)))
typedef unsigned short bf16_t;
typedef short bf16x8 __attribute__((ext_vector_type(8)));
typedef float f32x4 __attribute__((ext_vector_type(4)));
typedef unsigned u32x4 __attribute__((ext_vector_type(4)));
typedef int i32x4 __attribute__((ext_vector_type(4)));
constexpr int WCS = 64, BJS = 32;
constexpr int BM = 256, BK = 64, HALF = 128, HTB = HALF * BK * 2  , STAGE_BYTES = 8 * HTB, NXCD = 8, WGM = 8;

__host__ __device__ __forceinline__ int lds_byte(int r, int c) { const int st = (r >> 4) * 2 + (c >> 5), rr = r & 15, cc = c & 31, ob = rr * 64 + cc * 2; return st * 1024 + (ob ^ (((ob >> 9) & 1) << 5)); }
__host__ __device__ __forceinline__ void stage_rc(int b, int& R, int& C) { const int st = b / 1024, sb = b % 1024, swz = sb ^ (((sb >> 9) & 1) << 5); R = (st >> 1) * 16 + swz / 64; C = (st & 1) * 32 + (swz % 64) / 2; }
__host__ __device__ __forceinline__ int perm32(int rho) { const int n = rho >> 4, i = rho & 15; return 8 * (i >> 2) + 4 * n + (i & 3); }

struct Unit { int pm, pn, ko; };
struct Gemm { const bf16_t* A; const bf16_t* Bt; int M, N, K, lda, ldb; };

struct StaticOrder {
    int nM, nN, nwg, G, c;
    __host__ __device__ void init(int M, int N, int G_, int c_) { nM = M / BM; nN = N / BM; nwg = nM * nN; G = G_; c = c_; }
    __host__ __device__ bool next(int i, Unit& u) const {
        const long L = (long)i * G + c; if (L >= nwg) return false;
        int wgid = (int)L; { const int q = nwg / NXCD, r = nwg % NXCD, xcd = wgid % NXCD, off = wgid / NXCD; wgid = (xcd < r ? xcd * (q + 1) : r * (q + 1) + (xcd - r) * q) + off; }
        const int nig = WGM * nN, gid = wgid / nig, fm = gid * WGM, gsz = (nM - fm) < WGM ? (nM - fm) : WGM;
        u.pm = fm + ((wgid % nig) % gsz); u.pn = (wgid % nig) / gsz; u.ko = 0; return true;
    }
    __device__ __forceinline__ void a_ready(const Unit&) const {}
    __device__ __forceinline__ void done(const Unit&) const {}
};
struct PartOrder {
    int pm, l0, nl, h0, cnt;
    __host__ __device__ void init(int c, int NL) { const int x = c % NXCD, off = c / NXCD, gq = off / WGM; pm = x * WGM + off % WGM;
        if (gq == 0) { l0 = 0; nl = 1; h0 = NL; cnt = 5; } else { l0 = 1 + 3 * (gq - 1); nl = 3; h0 = NL + 4 + 4 * (gq - 1); cnt = 7; } }
    __host__ __device__ int tile(int i) const { return i < nl ? l0 + i : h0 + (i - nl); }
    __host__ __device__ int slot(int pn, int NL) const { return pn < NL ? pn - l0 : nl + pn - h0; }
    __host__ __device__ bool next(int i, Unit& u) const { if (i >= cnt) return false; u.pm = pm; u.pn = tile(i); u.ko = 0; return true; }
    __device__ __forceinline__ void a_ready(const Unit&) const {}
    __device__ __forceinline__ void done(const Unit&) const {}
};

__device__ __forceinline__ unsigned cvt_pk_bf16(float lo, float hi) { unsigned r; asm volatile("v_cvt_pk_bf16_f32 %0, %1, %2" : "=v"(r) : "v"(lo), "v"(hi)); return r; }
typedef float f32x2 __attribute__((ext_vector_type(2)));
struct EpiInproj {
    static constexpr bool PERM = true, AFTER_DRAIN = false, I8 = false; static constexpr int NST = 16;
    const float* SSQ; bf16_t *za, *zb, *zqkv, *zd; unsigned char* g; const PG8_LAS float* rtab; int pm_tab; unsigned char* wsb;
    __device__ __forceinline__ void operator()(const f32x4 (&acc)[2][2][4][2], const Unit& u, int wr, int wc, int fr, int fq) const {
        const int row0 = u.pm * BM + wr * 64 + fr, pn = u.pn;
        bf16_t* base = za; int ldc = 512, colt = pn * 256, mode = 1;
        if (pn >= 15) { mode = 2; colt = (pn - 15) * 256; }
        else if (pn >= 14) { base = zd; ldc = 256; colt = 0; mode = 0; }
        else if (pn >= 5) { base = zqkv; ldc = 2304; colt = (pn - 5) * 256; mode = 0; }
        else if (pn >= 2) { base = zb; ldc = 768; colt = (pn - 2) * 256; mode = 0; }
        const int col0 = colt + wc * WCS + 8 * fq;
        const __amdgpu_buffer_rsrc_t wrs = __builtin_amdgcn_make_buffer_rsrc(wsb, 0, (int)C::WS_END, 0x00020000);
        const size_t boff = (size_t)((const unsigned char*)base - wsb), goff = (size_t)(g - wsb);
        const float qsc = (pn >= 5 && pn < 8) ? 0.18033688011112042f : 1.0f;
        float rs[8];
        if (u.pm == pm_tab) {
#pragma unroll
            for (int i = 0; i < 8; ++i) rs[i] = rtab[wr * 64 + fr + (i >> 2) * HALF + (i & 3) * 16];
        } else {
#pragma unroll
            for (int i = 0; i < 8; ++i) { const f32x4 t = *(const f32x4*)(SSQ + (size_t)(row0 + (i >> 2) * HALF + (i & 3) * 16) * 16 + fq * 4); rs[i] = (t[0] + t[1]) + (t[2] + t[3]); }
#pragma unroll
            for (int i = 0; i < 8; ++i) { float v = rs[i]; v += swz_xor<16>(v); v = half_sum(v); rs[i] = rsqrtf(v * (1.0f / C::D) + C::EPS); }
        }
#pragma unroll
        for (int ai = 0; ai < 2; ++ai)
#pragma unroll
            for (int m = 0; m < 4; ++m) {
                const int row = row0 + ai * HALF + m * 16; const float rstd = rs[ai * 4 + m] * qsc;
#pragma unroll
                for (int bj = 0; bj < 2; ++bj) {
                    f32x4 v0 = acc[ai][bj][m][0] * rstd, v1 = acc[ai][bj][m][1] * rstd;
                    if (mode == 2) {
                        unsigned lo = 0, hi = 0;
#pragma unroll
                        for (int e = 0; e < 4; ++e) { lo = __builtin_amdgcn_cvt_pk_u8_f32(__builtin_floorf(sigmoidf_(v0[e]) * 255.0f + 0.5f), e, lo); hi = __builtin_amdgcn_cvt_pk_u8_f32(__builtin_floorf(sigmoidf_(v1[e]) * 255.0f + 0.5f), e, hi); }
                        typedef unsigned u32x2 __attribute__((ext_vector_type(2)));
                        __builtin_amdgcn_raw_buffer_store_b64((u32x2){lo, hi}, wrs, (unsigned)(goff + (size_t)row * 4096 + col0 + bj * BJS), 0, 16);
                    } else {
                        if (mode == 1) {
#pragma unroll
                            for (int e = 0; e < 4; ++e) { v0[e] = gelu_tanh(v0[e]); v1[e] = gelu_tanh(v1[e]); }
                        }
                        u32x4 w; w.x = cvt_pk_bf16(v0[0], v0[1]); w.y = cvt_pk_bf16(v0[2], v0[3]); w.z = cvt_pk_bf16(v1[0], v1[1]); w.w = cvt_pk_bf16(v1[2], v1[3]);
                        __builtin_amdgcn_raw_buffer_store_b128(w, wrs, (unsigned)(boff + ((size_t)row * ldc + col0 + bj * BJS) * 2), 0, 16);
                    }
                }
            }
    }
};
struct EpiInprojI8 {
    static constexpr bool PERM = true, AFTER_DRAIN = false, I8 = true; static constexpr int NST = 16;
    bf16_t *za, *zb, *zqkv, *zd; unsigned char* g; const PG8_LAS float *ctab, *xtab; unsigned char* wsb; int pn_off, l0, nl, h0;
    __device__ __forceinline__ void operator()(const f32x4 (&acc)[2][2][4][2], const Unit& u, int wr, int wc, int fr, int fq) const {
        const int row0 = u.pm * BM + wr * 64 + fr, pn = u.pn + pn_off;
        bf16_t* base = za; int ldc = 512, colt = pn * 256, mode = 1;
        if (pn >= 15) { mode = 2; colt = (pn - 15) * 256; }
        else if (pn >= 14) { base = zd; ldc = 256; colt = 0; mode = 0; }
        else if (pn >= 5) { base = zqkv; ldc = 2304; colt = (pn - 5) * 256; mode = 0; }
        else if (pn >= 2) { base = zb; ldc = 768; colt = (pn - 2) * 256; mode = 0; }
        const int col0 = colt + wc * WCS + 8 * fq;
        const __amdgpu_buffer_rsrc_t wrs = __builtin_amdgcn_make_buffer_rsrc(wsb, 0, (int)C::WS_END, 0x00020000);
        const size_t boff = (size_t)((const unsigned char*)base - wsb), goff = (size_t)(g - wsb);
        const float qsc = (pn >= 5 && pn < 8) ? 0.18033688011112042f : 1.0f;
        float xs[8];
#pragma unroll
        for (int i = 0; i < 8; ++i) xs[i] = xtab[wr * 64 + fr + (i >> 2) * HALF + (i & 3) * 16];
#pragma unroll
        for (int bj = 0; bj < 2; ++bj) {
            const PG8_LAS float* cp = ctab + (u.pn < 10 ? u.pn - l0 : nl + u.pn - h0) * 256 + wc * WCS + 8 * fq + bj * BJS; const f32x4 cf0 = *(const PG8_LAS f32x4*)cp * qsc, cf1 = *(const PG8_LAS f32x4*)(cp + 4) * qsc;
#pragma unroll
            for (int ai = 0; ai < 2; ++ai)
#pragma unroll
                for (int m = 0; m < 4; ++m) {
                    const int row = row0 + ai * HALF + m * 16;
                    {
                    const i32x4 a0 = __builtin_bit_cast(i32x4, acc[ai][bj][m][0]), a1 = __builtin_bit_cast(i32x4, acc[ai][bj][m][1]);
                    const float xf = xs[ai * 4 + m]; f32x4 v0 = __builtin_convertvector(a0, f32x4) * (cf0 * xf), v1 = __builtin_convertvector(a1, f32x4) * (cf1 * xf);
                    if (mode == 2) {
                        unsigned lo = 0, hi = 0;
#pragma unroll
                        for (int e = 0; e < 4; ++e) { lo = __builtin_amdgcn_cvt_pk_u8_f32(__builtin_floorf(sigmoidf_(v0[e]) * 255.0f + 0.5f), e, lo); hi = __builtin_amdgcn_cvt_pk_u8_f32(__builtin_floorf(sigmoidf_(v1[e]) * 255.0f + 0.5f), e, hi); }
                        typedef unsigned u32x2 __attribute__((ext_vector_type(2)));
                        __builtin_amdgcn_raw_buffer_store_b64((u32x2){lo, hi}, wrs, (unsigned)(goff + (size_t)row * 4096 + col0 + bj * BJS), 0, 16);
                    } else {
                        if (mode == 1) {
#pragma unroll
                            for (int e = 0; e < 4; ++e) { v0[e] = gelu_tanh(v0[e]); v1[e] = gelu_tanh(v1[e]); }
                        }
                        u32x4 w; w.x = cvt_pk_bf16(v0[0], v0[1]); w.y = cvt_pk_bf16(v0[2], v0[3]); w.z = cvt_pk_bf16(v1[0], v1[1]); w.w = cvt_pk_bf16(v1[2], v1[3]);
                        __builtin_amdgcn_raw_buffer_store_b128(w, wrs, (unsigned)(boff + ((size_t)row * ldc + col0 + bj * BJS) * 2), 0, 16);
                    }
                    }
                }
        }
    }
};
struct EpiFF1 {
    static constexpr bool PERM = true, AFTER_DRAIN = false, I8 = false; static constexpr int NST = 16;
    const float* SSQ; bf16_t* H; const PG8_LAS float* rtab; int pm_tab;
    __device__ __forceinline__ void operator()(const f32x4 (&acc)[2][2][4][2], const Unit& u, int wr, int wc, int fr, int fq) const {
        const int row0 = u.pm * BM + wr * 64 + fr, col0 = u.pn * BM + wc * WCS + 8 * fq;
        const __amdgpu_buffer_rsrc_t hrs = __builtin_amdgcn_make_buffer_rsrc(H, 0, (int)((size_t)C::T * C::DFF * 2), 0x00020000);
        float rs[8];
        if (u.pm == pm_tab) {
#pragma unroll
            for (int i = 0; i < 8; ++i) rs[i] = rtab[wr * 64 + fr + (i >> 2) * HALF + (i & 3) * 16];
        } else {
#pragma unroll
            for (int i = 0; i < 8; ++i) { const f32x4 t = *(const f32x4*)(SSQ + (size_t)(row0 + (i >> 2) * HALF + (i & 3) * 16) * 16 + fq * 4); rs[i] = (t[0] + t[1]) + (t[2] + t[3]); }
#pragma unroll
            for (int i = 0; i < 8; ++i) { float v = rs[i]; v += swz_xor<16>(v); v = half_sum(v); rs[i] = rsqrtf(v * (1.0f / C::D) + C::EPS); }
        }
#pragma unroll
        for (int ai = 0; ai < 2; ++ai)
#pragma unroll
            for (int m = 0; m < 4; ++m) {
                const int row = row0 + ai * HALF + m * 16; const float rstd = rs[ai * 4 + m];
#pragma unroll
                for (int bj = 0; bj < 2; ++bj) {
                    f32x4 v0 = acc[ai][bj][m][0] * rstd, v1 = acc[ai][bj][m][1] * rstd;
#pragma unroll
                    for (int e = 0; e < 4; ++e) { const float a = fmaxf(v0[e], 0.f), b = fmaxf(v1[e], 0.f); v0[e] = a * a; v1[e] = b * b; }
                    u32x4 w; w.x = cvt_pk_bf16(v0[0], v0[1]); w.y = cvt_pk_bf16(v0[2], v0[3]); w.z = cvt_pk_bf16(v1[0], v1[1]); w.w = cvt_pk_bf16(v1[2], v1[3]);
                    __builtin_amdgcn_raw_buffer_store_b128(w, hrs, (unsigned)(((size_t)row * C::DFF + col0 + bj * BJS) * 2), 0, 16);
                }
            }
    }
};
struct EpiFF1I8 {
    static constexpr bool PERM = true, AFTER_DRAIN = false, I8 = true; static constexpr int NST = 16;
    bf16_t* H; const PG8_LAS float *ctab, *xtab;
    __device__ __forceinline__ void operator()(const f32x4 (&acc)[2][2][4][2], const Unit& u, int wr, int wc, int fr, int fq) const {
        const int row0 = u.pm * BM + wr * 64 + fr, col0 = u.pn * BM + wc * WCS + 8 * fq;
        const __amdgpu_buffer_rsrc_t hrs = __builtin_amdgcn_make_buffer_rsrc(H, 0, (int)((size_t)C::T * C::DFF * 2), 0x00020000);
        float xs[8];
#pragma unroll
        for (int i = 0; i < 8; ++i) xs[i] = xtab[wr * 64 + fr + (i >> 2) * HALF + (i & 3) * 16];
#pragma unroll
        for (int bj = 0; bj < 2; ++bj) {
            const PG8_LAS float* cp = ctab + (u.pn >> 2) * 256 + wc * WCS + 8 * fq + bj * BJS; const f32x4 cf0 = *(const PG8_LAS f32x4*)cp, cf1 = *(const PG8_LAS f32x4*)(cp + 4);
#pragma unroll
            for (int ai = 0; ai < 2; ++ai)
#pragma unroll
                for (int m = 0; m < 4; ++m) {
                    const int row = row0 + ai * HALF + m * 16;
                    const i32x4 a0 = __builtin_bit_cast(i32x4, acc[ai][bj][m][0]), a1 = __builtin_bit_cast(i32x4, acc[ai][bj][m][1]);
                    const float xf = xs[ai * 4 + m]; f32x4 v0 = __builtin_convertvector(a0, f32x4) * (cf0 * xf), v1 = __builtin_convertvector(a1, f32x4) * (cf1 * xf);
#pragma unroll
                    for (int e = 0; e < 4; ++e) { const float a = fmaxf(v0[e], 0.f), b = fmaxf(v1[e], 0.f); v0[e] = a * a; v1[e] = b * b; }
                    u32x4 w; w.x = cvt_pk_bf16(v0[0], v0[1]); w.y = cvt_pk_bf16(v0[2], v0[3]); w.z = cvt_pk_bf16(v1[0], v1[1]); w.w = cvt_pk_bf16(v1[2], v1[3]);
                    __builtin_amdgcn_raw_buffer_store_b128(w, hrs, (unsigned)(((size_t)row * C::DFF + col0 + bj * BJS) * 2), 0, 16);
                }
        }
    }
};
struct EpiResid {
    static constexpr bool PERM = true, AFTER_DRAIN = false, I8 = false; static constexpr int NST = 0;
    bf16_t* XB; float* SSQ;
    __device__ __forceinline__ void operator()(const f32x4 (&acc)[2][2][4][2], const Unit& u, int wr, int wc, int fr, int fq) const {
        const int row0 = u.pm * BM + wr * 64 + fr, col0 = u.pn * BM + wc * WCS + 8 * fq;
        u32x4 xv[2][4][2];
#pragma unroll
        for (int ai = 0; ai < 2; ++ai)
#pragma unroll
            for (int m = 0; m < 4; ++m)
#pragma unroll
                for (int bj = 0; bj < 2; ++bj) xv[ai][m][bj] = *(const u32x4*)(XB + (size_t)(row0 + ai * HALF + m * 16) * C::D + col0 + bj * BJS);
        asm volatile("" ::: "memory");
#pragma unroll
        for (int ai = 0; ai < 2; ++ai)
#pragma unroll
            for (int m = 0; m < 4; ++m) {
                const int row = row0 + ai * HALF + m * 16; float ss = 0.f;
#pragma unroll
                for (int bj = 0; bj < 2; ++bj) {
                    const u32x4 xr = xv[ai][m][bj]; u32x4 w;
#pragma unroll
                    for (int q = 0; q < 4; ++q) {
                        const f32x4& a = acc[ai][bj][m][q >> 1];
                        const float y0 = __uint_as_float(xr[q] << 16) + a[2 * (q & 1)], y1 = __uint_as_float(xr[q] & 0xffff0000u) + a[2 * (q & 1) + 1];
                        w[q] = cvt_pk_bf16(y0, y1);
                        const float r0 = __uint_as_float(w[q] << 16), r1 = __uint_as_float(w[q] & 0xffff0000u);
                        ss += r0 * r0 + r1 * r1;
                    }
                    *(u32x4*)(XB + (size_t)row * C::D + col0 + bj * BJS) = w;
                }
                ss += swz_xor<16>(ss); ss = half_sum(ss);
                if (fq == 0) SSQ[(size_t)row * 16 + u.pn * 4 + wc] = ss;
            }
    }
};
template <bool I8> __device__ __forceinline__ f32x4 mma16(bf16x8 b, bf16x8 a, f32x4 c) {
    if constexpr (I8) return __builtin_bit_cast(f32x4, __builtin_amdgcn_mfma_i32_16x16x64_i8(__builtin_bit_cast(i32x4, b), __builtin_bit_cast(i32x4, a), __builtin_bit_cast(i32x4, c), 0, 0, 0));
    else return __builtin_amdgcn_mfma_f32_16x16x32_bf16(b, a, c, 0, 0, 0);
}
template <class Epi, class Sched, bool ALIGN_EPI = false, bool SP2 = false>
__device__ __forceinline__ void gemm_phase(PG8_LAS unsigned char* lds, const Gemm g, const Sched& S, const Epi& E, const int wid_in) {
    int lane; asm volatile("v_mbcnt_lo_u32_b32 %0, -1, 0\n\tv_mbcnt_hi_u32_b32 %0, -1, %0" : "=v"(lane));
    const int wid = wid_in, tid = wid * 64 + lane, wr = wid >> 2, wc = wid & 3, fr = lane & 15, fq = lane >> 4;
    const int K = g.K, nt = K / BK;
    unsigned voffA[2], voffB[2];
#pragma unroll
    for (int i = 0; i < 2; ++i) { int R, C; stage_rc(tid * 16 + i * 8192, R, C); const int Rb = Epi::PERM ? (WCS * (R >> 5) + perm32(R & 31)) : R;
        voffA[i] = (unsigned)(R * g.lda + C) * 2u; voffB[i] = (unsigned)(Rb * g.ldb + C) * 2u; }
    const size_t kstep = (size_t)(BK * 2);
    const size_t hstepA = (size_t)HALF * g.lda * 2, hstepB = (size_t)BJS * g.ldb * 2;
    const size_t tstepA = 2 * hstepA, tstepB = (size_t)BM * g.ldb * 2;
    const unsigned ldsw = (unsigned)wid * 1024u;
    const int aoff = lds_byte(wr * 64 + fr, fq * 8), boff = lds_byte(wc * 32 + fr, fq * 8);
#define PG8_SA(b, h) (((b) * 2 + (h)) * HTB)
#define PG8_SB(b, h) ((4 + (b) * 2 + (h)) * HTB)
#define PG8_STAGE(bufoff, gbase, voff) do { _Pragma("unroll") for (int _i = 0; _i < 2; ++_i) \
        __builtin_amdgcn_global_load_lds((const unsigned*)((const char*)(gbase) + (voff)[_i]), (PG8_LAS unsigned*)(lds + (bufoff) + ldsw + _i * 8192), 16, 0, 0); } while (0)
#define PG8_LDA(dst, b, h) do { _Pragma("unroll") for (int m = 0; m < 4; ++m) _Pragma("unroll") for (int k = 0; k < 2; ++k) dst[m][k] = *(const PG8_LAS bf16x8*)(lds + PG8_SA(b, h) + aoff + m * 2048 + k * 1024); } while (0)
#define PG8_LDB(dst, b, h) do { _Pragma("unroll") for (int n = 0; n < 2; ++n) _Pragma("unroll") for (int k = 0; k < 2; ++k) dst[n][k] = *(const PG8_LAS bf16x8*)(lds + PG8_SB(b, h) + boff + n * 2048 + k * 1024); } while (0)
#define PG8_MMA(ai, bj, At, Bt) do { __builtin_amdgcn_s_setprio(1); _Pragma("unroll") for (int m = 0; m < 4; ++m) _Pragma("unroll") for (int n = 0; n < 2; ++n) _Pragma("unroll") for (int k = 0; k < 2; ++k) \
        acc[ai][bj][m][n] = mma16<Epi::I8>(Bt[n][k], At[m][k], acc[ai][bj][m][n]); __builtin_amdgcn_s_setprio(0); } while (0)
#define PG8_WAIT_V(n) asm volatile("s_waitcnt vmcnt(" #n ")" ::: "memory")
#define PG8_WAIT_L(n) asm volatile("s_waitcnt lgkmcnt(" #n ")" ::: "memory")
#define PG8_BAR __builtin_amdgcn_s_barrier()
#define PG8_SCHED __builtin_amdgcn_sched_barrier(0)
    Unit cur, nxt; int ui = 0;
    if (!S.next(0, cur)) return;
    f32x4 acc[2][2][4][2];
#pragma unroll
    for (int a = 0; a < 2; ++a)
#pragma unroll
        for (int b = 0; b < 2; ++b)
#pragma unroll
            for (int m = 0; m < 4; ++m)
#pragma unroll
                for (int n = 0; n < 2; ++n) acc[a][b][m][n] = (f32x4){0.f, 0.f, 0.f, 0.f};
    bf16x8 At[4][2], B0[2][2], B1[2][2];
    const char* cA = (const char*)g.A + (size_t)cur.pm * tstepA + (size_t)cur.ko * 2; const char* cB = (const char*)g.Bt + (size_t)cur.pn * tstepB + (size_t)cur.ko * 2;
    S.a_ready(cur);
    if constexpr (SP2) {
        PG8_STAGE(PG8_SB(0, 0), cB, voffB); PG8_STAGE(PG8_SB(0, 1), cB + hstepB, voffB); PG8_STAGE(PG8_SA(0, 0), cA, voffA); PG8_STAGE(PG8_SA(0, 1), cA + hstepA, voffA);
        if (wr == 1) PG8_BAR;
        PG8_WAIT_V(2); PG8_BAR;
        PG8_STAGE(PG8_SB(1, 0), cB + kstep, voffB); PG8_STAGE(PG8_SA(1, 0), cA + kstep, voffA); PG8_STAGE(PG8_SB(1, 1), cB + hstepB + kstep, voffB);
        PG8_WAIT_V(6); PG8_BAR;
    } else {
        PG8_STAGE(PG8_SB(0, 0), cB, voffB); PG8_STAGE(PG8_SA(0, 0), cA, voffA); PG8_STAGE(PG8_SB(0, 1), cB + hstepB, voffB); PG8_STAGE(PG8_SA(0, 1), cA + hstepA, voffA);
        if (wr == 1) PG8_BAR;
        PG8_WAIT_V(4); PG8_BAR;
        PG8_STAGE(PG8_SB(1, 0), cB + kstep, voffB); PG8_STAGE(PG8_SA(1, 0), cA + kstep, voffA); PG8_STAGE(PG8_SB(1, 1), cB + hstepB + kstep, voffB);
        PG8_WAIT_V(6); PG8_BAR;
    }
    for (;;) {
        const bool has_next = S.next(ui + 1, nxt);
        const char* nA = has_next ? (const char*)g.A + (size_t)nxt.pm * tstepA + (size_t)nxt.ko * 2 : cA; const char* nB = has_next ? (const char*)g.Bt + (size_t)nxt.pn * tstepB + (size_t)nxt.ko * 2 : cB;
        for (int t = 0; t < nt; t += 2) {
            const bool last = (t == nt - 2);
            const char* a1 = cA + (size_t)(t + 1) * kstep;
            const char* a2 = last ? nA : cA + (size_t)(t + 2) * kstep; const char* b2 = last ? nB : cB + (size_t)(t + 2) * kstep;
            const char* a3 = a2 + kstep; const char* b3 = b2 + kstep;
            if (last && has_next) S.a_ready(nxt);
            if constexpr (SP2) {
            PG8_LDB(B0, 0, 0); PG8_LDB(B1, 0, 1); PG8_SCHED; PG8_LDA(At, 0, 0); PG8_STAGE(PG8_SA(1, 1), a1 + hstepA, voffA);
            PG8_WAIT_V(8); PG8_WAIT_L(0); PG8_BAR; PG8_MMA(0, 0, At, B0); PG8_MMA(0, 1, At, B1); PG8_BAR; PG8_SCHED;
            PG8_LDA(At, 0, 1); PG8_STAGE(PG8_SB(0, 0), b2, voffB); PG8_STAGE(PG8_SB(0, 1), b2 + hstepB, voffB); PG8_STAGE(PG8_SA(0, 0), a2, voffA);
            PG8_WAIT_V(8); PG8_WAIT_L(0); PG8_BAR; PG8_MMA(1, 0, At, B0); PG8_MMA(1, 1, At, B1); PG8_BAR; PG8_SCHED;
            PG8_LDB(B0, 1, 0); PG8_LDB(B1, 1, 1); PG8_SCHED; PG8_LDA(At, 1, 0); PG8_STAGE(PG8_SA(0, 1), a2 + hstepA, voffA);
            PG8_WAIT_V(8); PG8_WAIT_L(0); PG8_BAR; PG8_MMA(0, 0, At, B0); PG8_MMA(0, 1, At, B1); PG8_BAR; PG8_SCHED;
            PG8_LDA(At, 1, 1); PG8_STAGE(PG8_SB(1, 0), b3, voffB); PG8_STAGE(PG8_SB(1, 1), b3 + hstepB, voffB); PG8_STAGE(PG8_SA(1, 0), a3, voffA);
            PG8_WAIT_V(8); PG8_WAIT_L(0); PG8_BAR; PG8_MMA(1, 0, At, B0); PG8_MMA(1, 1, At, B1); PG8_BAR; PG8_SCHED;
            } else {
            PG8_LDB(B0, 0, 0); PG8_SCHED; PG8_LDA(At, 0, 0); PG8_STAGE(PG8_SA(1, 1), a1 + hstepA, voffA);
            PG8_WAIT_L(8); PG8_BAR; PG8_WAIT_L(0); PG8_MMA(0, 0, At, B0); PG8_BAR; PG8_SCHED;
            PG8_LDB(B1, 0, 1); PG8_STAGE(PG8_SB(0, 0), b2, voffB);
            PG8_BAR; PG8_WAIT_L(0); PG8_MMA(0, 1, At, B1); PG8_BAR;
            PG8_LDA(At, 0, 1); PG8_STAGE(PG8_SA(0, 0), a2, voffA);
            PG8_BAR; PG8_WAIT_L(0); PG8_MMA(1, 0, At, B0); PG8_BAR; PG8_SCHED;
            PG8_STAGE(PG8_SB(0, 1), b2 + hstepB, voffB);
            PG8_WAIT_V(6); PG8_BAR; PG8_MMA(1, 1, At, B1); PG8_BAR;
            PG8_LDB(B0, 1, 0); PG8_SCHED; PG8_LDA(At, 1, 0); PG8_STAGE(PG8_SA(0, 1), a2 + hstepA, voffA);
            PG8_WAIT_L(8); PG8_BAR; PG8_WAIT_L(0); PG8_MMA(0, 0, At, B0); PG8_BAR; PG8_SCHED;
            PG8_LDB(B1, 1, 1); PG8_STAGE(PG8_SB(1, 0), b3, voffB);
            PG8_BAR; PG8_WAIT_L(0); PG8_MMA(0, 1, At, B1); PG8_BAR;
            PG8_LDA(At, 1, 1); PG8_STAGE(PG8_SA(1, 0), a3, voffA);
            PG8_BAR; PG8_WAIT_L(0); PG8_MMA(1, 0, At, B0); PG8_BAR; PG8_SCHED;
            PG8_STAGE(PG8_SB(1, 1), b3 + hstepB, voffB);
            PG8_WAIT_V(6); PG8_BAR; PG8_MMA(1, 1, At, B1); PG8_BAR;
            }
        }
        if constexpr (ALIGN_EPI) { if (wr == 0) PG8_BAR; }
        if constexpr (!Epi::AFTER_DRAIN) { E(acc, cur, wr, wc, fr, fq); S.done(cur); }
        if (!has_next) break;
#pragma unroll
        for (int a = 0; a < 2; ++a)
#pragma unroll
            for (int b = 0; b < 2; ++b)
#pragma unroll
                for (int m = 0; m < 4; ++m)
#pragma unroll
                    for (int n = 0; n < 2; ++n) acc[a][b][m][n] = (f32x4){0.f, 0.f, 0.f, 0.f};
        cur = nxt; cA = nA; cB = nB; ++ui;
        if constexpr (ALIGN_EPI) { if (wr == 1) PG8_BAR; }
    }
    PG8_WAIT_V(0);
    if constexpr (!ALIGN_EPI) { if (wr == 0) PG8_BAR; }
    PG8_BAR;
    if constexpr (Epi::AFTER_DRAIN) { E.fused(acc, cur, wr, wc, fr, fq, lds, wid, lane); S.done(cur); }
#undef PG8_SA
#undef PG8_SB
#undef PG8_STAGE
#undef PG8_LDA
#undef PG8_LDB
#undef PG8_MMA
#undef PG8_WAIT_V
#undef PG8_WAIT_L
#undef PG8_BAR
#undef PG8_SCHED
}
}
namespace pg8 {
__device__ __forceinline__ void gemm_merge_phase(PG8_LAS unsigned char* lds, const bf16_t* A, const bf16_t* Bt, const unsigned char* G, bf16_t* O, const int vcu, const int nwgs, const int wid_in) {
    int lane; asm volatile("v_mbcnt_lo_u32_b32 %0, -1, 0\n\tv_mbcnt_hi_u32_b32 %0, -1, %0" : "=v"(lane));
    const int wid = wid_in, tid = wid * 64 + lane, wr = wid >> 2, wc = wid & 3, fr = lane & 15, fq = lane >> 4;
    constexpr int K = C::D, nt = K / BK, LD = C::D;
    constexpr int NUNITS = (C::T / 256) * (C::D / 128);
    unsigned voffA[2], voffB[2];
#pragma unroll
    for (int i = 0; i < 2; ++i) { int R, Cc; stage_rc(tid * 16 + i * 8192, R, Cc); const int Rb = (R & ~31) + perm32(R & 31);
        voffA[i] = (unsigned)(R * LD + Cc) * 2u; voffB[i] = (unsigned)(Rb * LD + Cc) * 2u; }
    constexpr size_t kstep = (size_t)(BK * 2), hstep = (size_t)HALF * LD * 2;
    const unsigned ldsw = (unsigned)wid * 1024u;
    const int aoff = lds_byte(wr * 64 + fr, fq * 8), boff = lds_byte(wc * 32 + fr, fq * 8);
#define PG8_SA(b, h) (((b) * 2 + (h)) * HTB)
#define PG8_SB(b, h) ((4 + (b) * 2 + (h)) * HTB)
#define PG8_STAGE(bufoff, gbase, voff) do { _Pragma("unroll") for (int _i = 0; _i < 2; ++_i) \
        __builtin_amdgcn_global_load_lds((const unsigned*)((const char*)(gbase) + (voff)[_i]), (PG8_LAS unsigned*)(lds + (bufoff) + ldsw + _i * 8192), 16, 0, 0); } while (0)
#define PG8_LDA(dst, b, h) do { _Pragma("unroll") for (int m = 0; m < 4; ++m) _Pragma("unroll") for (int k = 0; k < 2; ++k) dst[m][k] = *(const PG8_LAS bf16x8*)(lds + PG8_SA(b, h) + aoff + m * 2048 + k * 1024); } while (0)
#define PG8_LDB(dst, b, h) do { _Pragma("unroll") for (int n = 0; n < 2; ++n) _Pragma("unroll") for (int k = 0; k < 2; ++k) dst[n][k] = *(const PG8_LAS bf16x8*)(lds + PG8_SB(b, h) + boff + n * 2048 + k * 1024); } while (0)
#define PG8_MMA(ai, At, Bt) do { __builtin_amdgcn_s_setprio(1); _Pragma("unroll") for (int m = 0; m < 4; ++m) _Pragma("unroll") for (int n = 0; n < 2; ++n) _Pragma("unroll") for (int k = 0; k < 2; ++k) \
        acc[ai][m][n] = __builtin_amdgcn_mfma_f32_16x16x32_bf16(Bt[n][k], At[m][k], acc[ai][m][n], 0, 0, 0); __builtin_amdgcn_s_setprio(0); } while (0)
#define PG8_WAIT_V(n) asm volatile("s_waitcnt vmcnt(" #n ")" ::: "memory")
#define PG8_WAIT_L(n) asm volatile("s_waitcnt lgkmcnt(" #n ")" ::: "memory")
#define PG8_BAR __builtin_amdgcn_s_barrier()
#define PG8_SCHED __builtin_amdgcn_sched_barrier(0)
    int L = vcu;
    if (L >= NUNITS) return;
    f32x4 acc[2][4][2], tot[2][4][2];
#pragma unroll
    for (int a = 0; a < 2; ++a)
#pragma unroll
        for (int m = 0; m < 4; ++m)
#pragma unroll
            for (int n = 0; n < 2; ++n) { acc[a][m][n] = (f32x4){0.f, 0.f, 0.f, 0.f}; tot[a][m][n] = (f32x4){0.f, 0.f, 0.f, 0.f}; }
    bf16x8 At[4][2], B0[2][2];
    const char* cA = (const char*)A + (size_t)(L >> 3) * (2 * hstep); const char* cB = (const char*)Bt + (size_t)(L & 7) * hstep;
    PG8_STAGE(PG8_SB(0, 0), cB, voffB); PG8_STAGE(PG8_SA(0, 0), cA, voffA); PG8_STAGE(PG8_SA(0, 1), cA + hstep, voffA);
    if (wr == 1) PG8_BAR;
    PG8_WAIT_V(2); PG8_BAR;
    PG8_STAGE(PG8_SB(1, 0), cB + kstep, voffB); PG8_STAGE(PG8_SA(1, 0), cA + kstep, voffA);
    PG8_WAIT_V(4); PG8_BAR;
    for (;;) {
        const int Ln = L + nwgs; const bool has_next = Ln < NUNITS;
        const char* nA = has_next ? (const char*)A + (size_t)(Ln >> 3) * (2 * hstep) : cA; const char* nB = has_next ? (const char*)Bt + (size_t)(Ln & 7) * hstep : cB;
        const int row0 = (L >> 3) * BM + wr * 64 + fr, col0 = (L & 7) * HALF + wc * 32 + 8 * fq;
#pragma unroll 1
        for (int seg = 0; seg < 4; ++seg) {
            typedef unsigned u32x2 __attribute__((ext_vector_type(2)));
            u32x2 gv[2][4];
            int r0g = row0; asm volatile("" : "+v"(r0g));
#pragma unroll
            for (int ai = 0; ai < 2; ++ai)
#pragma unroll
                for (int m = 0; m < 4; ++m) gv[ai][m] = *(const u32x2*)(G + (size_t)(r0g + ai * HALF + m * 16) * 4096 + seg * 1024 + col0);
#pragma unroll
            for (int h2 = 0; h2 < 2; ++h2) {
                const int t = seg * 4 + h2 * 2;
                const bool last = (t == nt - 2);
                const char* a1 = cA + (size_t)(t + 1) * kstep;
                const char* a2 = last ? nA : cA + (size_t)(t + 2) * kstep; const char* b2 = last ? nB : cB + (size_t)(t + 2) * kstep;
                const char* a3 = a2 + kstep; const char* b3 = b2 + kstep;
                PG8_LDB(B0, 0, 0); PG8_SCHED; PG8_LDA(At, 0, 0); PG8_STAGE(PG8_SA(1, 1), a1 + hstep, voffA);
                PG8_WAIT_V(6); PG8_WAIT_L(0); PG8_BAR; PG8_MMA(0, At, B0); PG8_BAR; PG8_SCHED;
                PG8_LDA(At, 0, 1); PG8_STAGE(PG8_SB(0, 0), b2, voffB); PG8_STAGE(PG8_SA(0, 0), a2, voffA);
                PG8_WAIT_V(6); PG8_WAIT_L(0); PG8_BAR; PG8_MMA(1, At, B0); PG8_BAR; PG8_SCHED;
                PG8_LDB(B0, 1, 0); PG8_SCHED; PG8_LDA(At, 1, 0); PG8_STAGE(PG8_SA(0, 1), a2 + hstep, voffA);
                PG8_WAIT_V(6); PG8_WAIT_L(0); PG8_BAR; PG8_MMA(0, At, B0); PG8_BAR; PG8_SCHED;
                PG8_LDA(At, 1, 1); PG8_STAGE(PG8_SB(1, 0), b3, voffB); PG8_STAGE(PG8_SA(1, 0), a3, voffA);
                PG8_WAIT_V(6); PG8_WAIT_L(0); PG8_BAR; PG8_MMA(1, At, B0); PG8_BAR; PG8_SCHED;
            }
#pragma unroll
            for (int ai = 0; ai < 2; ++ai)
#pragma unroll
                for (int m = 0; m < 4; ++m) {
                    const u32x2 gb = gv[ai][m];
#pragma unroll
                    for (int q = 0; q < 4; ++q) {
                        tot[ai][m][0][q] += (float)((gb.x >> (8 * q)) & 255u) * (1.0f / 255.0f) * acc[ai][m][0][q];
                        tot[ai][m][1][q] += (float)((gb.y >> (8 * q)) & 255u) * (1.0f / 255.0f) * acc[ai][m][1][q];
                    }
                    acc[ai][m][0] = (f32x4){0.f, 0.f, 0.f, 0.f}; acc[ai][m][1] = (f32x4){0.f, 0.f, 0.f, 0.f};
                }
        }
        int r0e = row0; asm volatile("" : "+v"(r0e));
#pragma unroll
        for (int ai = 0; ai < 2; ++ai)
#pragma unroll
            for (int m = 0; m < 4; ++m) {
                const f32x4 v0 = tot[ai][m][0], v1 = tot[ai][m][1];
                u32x4 w; w.x = cvt_pk_bf16(v0[0], v0[1]); w.y = cvt_pk_bf16(v0[2], v0[3]); w.z = cvt_pk_bf16(v1[0], v1[1]); w.w = cvt_pk_bf16(v1[2], v1[3]);
                *(u32x4*)(O + (size_t)(r0e + ai * HALF + m * 16) * C::D + col0) = w;
                tot[ai][m][0] = (f32x4){0.f, 0.f, 0.f, 0.f}; tot[ai][m][1] = (f32x4){0.f, 0.f, 0.f, 0.f};
            }
        if (!has_next) break;
        L = Ln; cA = nA; cB = nB;
    }
    PG8_WAIT_V(0);
    if (wr == 0) PG8_BAR;
    PG8_BAR;
#undef PG8_SA
#undef PG8_SB
#undef PG8_STAGE
#undef PG8_LDA
#undef PG8_LDB
#undef PG8_MMA
#undef PG8_WAIT_V
#undef PG8_WAIT_L
#undef PG8_BAR
#undef PG8_SCHED
}
}
#define XB_TMO      128
#define XB_XCNT(j)  (256  + 64 * (j))
#define XB_XSUB(j)  (1280 + 64 * (j))
#define XB_XGEN(j)  (2304 + 64 * (j))
#define XB_TOP      3328
#define XB_TOPGEN   3392
#define XCD_BAR_WORDS 3456
#define XB_SPIN_CAP (1u << 18)

__device__ __forceinline__ unsigned xb_ld(unsigned* p)              { return __hip_atomic_load(p, __ATOMIC_RELAXED, __HIP_MEMORY_SCOPE_AGENT); }
__device__ __forceinline__ unsigned xb_add(unsigned* p, unsigned v) { return __hip_atomic_fetch_add(p, v, __ATOMIC_RELAXED, __HIP_MEMORY_SCOPE_AGENT); }
__device__ __forceinline__ unsigned xb_xcc_id() { return (unsigned)__builtin_amdgcn_s_getreg((3 << 11) | 20) & 0xFu; }
#define XB_SPIN(cond, bar) do { unsigned _sp = 0; while (cond) { __builtin_amdgcn_s_sleep(1); \
    if ((++_sp & 255u) == 0u) { if (xb_ld(&(bar)[XB_TMO])) break; if (_sp > XB_SPIN_CAP) { atomicAdd(&(bar)[XB_TMO], 1u); break; } } } } while (0)

struct XcdBarrier {
    unsigned* bar; unsigned x;
    volatile LAS unsigned* st;
};

__device__ __forceinline__ XcdBarrier xcd_barrier_post(unsigned* bar, volatile LAS unsigned* st) {
    XcdBarrier b; b.bar = bar; b.x = xb_xcc_id(); b.st = st;
    if (threadIdx.x == 0) (void)xb_add(&bar[XB_XCNT(b.x)], 1u);
    return b;
}
__device__ __forceinline__ void xcd_barrier_complete(unsigned* bar, unsigned x, unsigned& nloc, unsigned& nx) {
    const unsigned G = gridDim.x * gridDim.y * gridDim.z;
    unsigned sum, cnt, mine, sp = 0u;
    for (;;) {
        sum = 0u; cnt = 0u; mine = 0u;
#pragma unroll
        for (unsigned j = 0; j < 16; ++j) { const unsigned c = xb_ld(&bar[XB_XCNT(j)]); sum += c; cnt += (c > 0u) ? 1u : 0u; mine = (j == x) ? c : mine; }
        if (sum == G) break;
        __builtin_amdgcn_s_sleep(1);
        if ((++sp & 255u) == 0u) { if (xb_ld(&bar[XB_TMO])) break; if (sp > XB_SPIN_CAP) { atomicAdd(&bar[XB_TMO], 1u); break; } }
    }
    nloc = mine > 0u ? mine : 1u; nx = cnt > 0u ? cnt : 1u;
}

__device__ __forceinline__ void xcd_barrier(const XcdBarrier& b) {
    asm volatile("s_waitcnt vmcnt(0)" ::: "memory");
    __syncthreads();
    if (threadIdx.x == 0) {
        unsigned* bar = b.bar;
        __builtin_amdgcn_s_waitcnt(0);
        unsigned nloc = b.st[0], nx = b.st[1];
        if (nloc == 0u) { xcd_barrier_complete(bar, b.x, nloc, nx); b.st[0] = nloc; b.st[1] = nx; }
        const unsigned old = xb_add(&bar[XB_XSUB(b.x)], 1u);
        const unsigned gen = old / nloc;
        if (old + 1u == (gen + 1u) * nloc) {
            __builtin_amdgcn_fence(__ATOMIC_RELEASE, "agent");
            asm volatile("s_waitcnt vmcnt(0)" ::: "memory");
            const unsigned og = xb_add(&bar[XB_TOP], 1u);
            const unsigned tg = og / nx;
            if (og + 1u == (tg + 1u) * nx) xb_add(&bar[XB_TOPGEN], 1u);
            else XB_SPIN(xb_ld(&bar[XB_TOPGEN]) == tg, bar);
            __builtin_amdgcn_fence(__ATOMIC_ACQUIRE, "agent");
            xb_add(&bar[XB_XGEN(b.x)], 1u);
            asm volatile("s_waitcnt vmcnt(0)" ::: "memory");
        } else {
            XB_SPIN(xb_ld(&bar[XB_XGEN(b.x)]) == gen, bar);
            __builtin_amdgcn_fence(__ATOMIC_ACQUIRE, "agent");
            asm volatile("s_waitcnt vmcnt(0)" ::: "memory");
        }
    }
    __syncthreads();
}
typedef unsigned short bf16_t;
typedef short bf16x8 __attribute__((ext_vector_type(8)));
typedef float f32x4 __attribute__((ext_vector_type(4)));
typedef unsigned u32x4 __attribute__((ext_vector_type(4)));
typedef unsigned u32x2 __attribute__((ext_vector_type(2)));

__device__ __forceinline__ unsigned q8pack(float a, float b, float c, float d, float s) {
    const int qa = (int)__builtin_rintf(fminf(fmaxf(a * s, -127.f), 127.f)), qb = (int)__builtin_rintf(fminf(fmaxf(b * s, -127.f), 127.f)), qc = (int)__builtin_rintf(fminf(fmaxf(c * s, -127.f), 127.f)), qd = (int)__builtin_rintf(fminf(fmaxf(d * s, -127.f), 127.f));
    return (unsigned)(qa & 255) | ((unsigned)(qb & 255) << 8) | ((unsigned)(qc & 255) << 16) | ((unsigned)(qd & 255) << 24);
}
__device__ __forceinline__ void ph_prologue(const float* __restrict__ x, bf16_t* __restrict__ XB, float* __restrict__ SSQ, unsigned char* __restrict__ XQ, float* __restrict__ XS, int gw, int ngw, int lane) {
    for (int row = gw; row < C::T; row += ngw) {
        const f32x4* xr = (const f32x4*)(x + (size_t)row * C::D) + lane;
        u32x2* br = (u32x2*)(XB + (size_t)row * C::D) + lane;
        f32x4 v[4]; float s = 0.f, amx = 0.f;
#pragma unroll
        for (int j = 0; j < 4; ++j) v[j] = __builtin_nontemporal_load(xr + 64 * j);
#pragma unroll
        for (int j = 0; j < 4; ++j) { u32x2 w; w.x = pk2(v[j].x, v[j].y); w.y = pk2(v[j].z, v[j].w); br[64 * j] = w;
            const float a = __uint_as_float(w.x << 16), b = __uint_as_float(w.x & 0xffff0000u), c = __uint_as_float(w.y << 16), d = __uint_as_float(w.y & 0xffff0000u); s += (a * a + b * b) + (c * c + d * d);
            amx = fmaxf(fmaxf(amx, fmaxf(fabsf(a), fabsf(b))), fmaxf(fabsf(c), fabsf(d))); v[j] = (f32x4){a, b, c, d}; }
        s = wave_sum(s);
        if (lane < 4) { f32x4 o = {lane == 0 ? s : 0.f, 0.f, 0.f, 0.f}; *(f32x4*)(SSQ + (size_t)row * 16 + lane * 4) = o; }
        amx = fmaxf(amx, swz_xor<1>(amx)); amx = fmaxf(amx, swz_xor<2>(amx)); amx = fmaxf(amx, swz_xor<4>(amx)); amx = fmaxf(amx, swz_xor<8>(amx)); amx = fmaxf(amx, swz_xor<16>(amx)); amx = half_max(amx);
        amx = fmaxf(amx, 1e-30f);
        const float qs = 127.0f / amx;
        unsigned* qr = (unsigned*)(XQ + (size_t)row * C::D) + lane;
#pragma unroll
        for (int j = 0; j < 4; ++j) qr[64 * j] = q8pack(v[j].x, v[j].y, v[j].z, v[j].w, qs);
        if (lane == 0) XS[row] = amx * (1.0f / 127.0f) * rsqrtf(s * (1.0f / C::D) + C::EPS);
    }
}
__device__ __forceinline__ float quant_row(const u32x4 a, const u32x4 b, u32x4& o) {
    float f[16];
    f[0] = __uint_as_float(a.x << 16); f[1] = __uint_as_float(a.x & 0xffff0000u); f[2] = __uint_as_float(a.y << 16); f[3] = __uint_as_float(a.y & 0xffff0000u);
    f[4] = __uint_as_float(a.z << 16); f[5] = __uint_as_float(a.z & 0xffff0000u); f[6] = __uint_as_float(a.w << 16); f[7] = __uint_as_float(a.w & 0xffff0000u);
    f[8] = __uint_as_float(b.x << 16); f[9] = __uint_as_float(b.x & 0xffff0000u); f[10] = __uint_as_float(b.y << 16); f[11] = __uint_as_float(b.y & 0xffff0000u);
    f[12] = __uint_as_float(b.z << 16); f[13] = __uint_as_float(b.z & 0xffff0000u); f[14] = __uint_as_float(b.w << 16); f[15] = __uint_as_float(b.w & 0xffff0000u);
    float amx = 0.f;
#pragma unroll
    for (int i = 0; i < 16; ++i) amx = fmaxf(amx, fabsf(f[i]));
    amx = fmaxf(amx, swz_xor<1>(amx)); amx = fmaxf(amx, swz_xor<2>(amx)); amx = fmaxf(amx, swz_xor<4>(amx)); amx = fmaxf(amx, swz_xor<8>(amx)); amx = fmaxf(amx, swz_xor<16>(amx)); amx = half_max(amx);
    amx = fmaxf(amx, 1e-30f);
    const float s = 127.0f / amx;
    o.x = q8pack(f[0], f[1], f[2], f[3], s); o.y = q8pack(f[4], f[5], f[6], f[7], s); o.z = q8pack(f[8], f[9], f[10], f[11], s); o.w = q8pack(f[12], f[13], f[14], f[15], s);
    return amx;
}
__device__ __forceinline__ void ph_quant(const bf16_t* __restrict__ W, unsigned char* __restrict__ Q, const size_t qstride, float* __restrict__ SC, const int n0, const int n1,
                                         const bf16_t* __restrict__ XB, const float* __restrict__ SSQ, unsigned char* __restrict__ XQ, float* __restrict__ XS, const bool do_x, int gw, int ngw, int lane) {
    for (int n = n0 + gw; n < n1; n += 2 * ngw) {
        const bool two = n + ngw < n1;
        const u32x4* s0 = (const u32x4*)(W + (size_t)n * C::D) + 2 * lane; const u32x4* s1 = (const u32x4*)(W + (size_t)(two ? n + ngw : n) * C::D) + 2 * lane;
        const u32x4 a0 = s0[0], b0 = s0[1], a1 = s1[0], b1 = s1[1];
        u32x4 o0, o1; const float m0 = quant_row(a0, b0, o0), m1 = quant_row(a1, b1, o1);
        *((u32x4*)(Q + (size_t)n * qstride) + lane) = o0;
        if (lane == 0) SC[n] = m0 * (1.0f / 127.0f);
        if (two) { *((u32x4*)(Q + (size_t)(n + ngw) * qstride) + lane) = o1; if (lane == 0) SC[n + ngw] = m1 * (1.0f / 127.0f); }
    }
    if (do_x) for (int row = gw; row < C::T; row += 4 * ngw) {
        u32x4 a[4], b[4]; float rstd[4];
#pragma unroll
        for (int r = 0; r < 4; ++r) { const int rr = (row + r * ngw < C::T) ? row + r * ngw : row; const u32x4* src = (const u32x4*)(XB + (size_t)rr * C::D) + 2 * lane; a[r] = src[0]; b[r] = src[1]; rstd[r] = row_rstd16(SSQ, rr); }
#pragma unroll
        for (int r = 0; r < 4; ++r) {
            u32x4 o; const float amx = quant_row(a[r], b[r], o);
            if (row + r * ngw < C::T) { *((u32x4*)(XQ + (size_t)(row + r * ngw) * C::D) + lane) = o; if (lane == 0) XS[row + r * ngw] = amx * (1.0f / 127.0f) * rstd[r]; }
        }
    }
}
__device__ __forceinline__ void ph_final(const bf16_t* __restrict__ XB, float* __restrict__ out, const float* __restrict__ g, const float* __restrict__ SSQ, int gw, int ngw, int lane) {
    const f32x4* gr = (const f32x4*)g + lane;
    f32x4 gg[4];
#pragma unroll
    for (int j = 0; j < 4; ++j) gg[j] = gr[64 * j];
    for (int row = 2 * gw; row < C::T; row += 2 * ngw) {
        u32x2 w[2][4]; float rstd[2];
#pragma unroll
        for (int r = 0; r < 2; ++r) { const u32x2* br = (const u32x2*)(XB + (size_t)(row + r) * C::D) + lane;
#pragma unroll
            for (int j = 0; j < 4; ++j) w[r][j] = __builtin_nontemporal_load(br + 64 * j);
            rstd[r] = row_rstd16(SSQ, row + r); }
#pragma unroll
        for (int r = 0; r < 2; ++r) { f32x4* orow = (f32x4*)(out + (size_t)(row + r) * C::D) + lane;
#pragma unroll
            for (int j = 0; j < 4; ++j) { f32x4 o;
                o.x = __uint_as_float(w[r][j].x << 16) * rstd[r] * gg[j].x; o.y = __uint_as_float(w[r][j].x & 0xffff0000u) * rstd[r] * gg[j].y; o.z = __uint_as_float(w[r][j].y << 16) * rstd[r] * gg[j].z; o.w = __uint_as_float(w[r][j].y & 0xffff0000u) * rstd[r] * gg[j].w;
                __builtin_nontemporal_store(o, orow + 64 * j); } }
    }
}
__device__ __forceinline__ void transpose_item(const float* __restrict__ W, int K, int N, bf16_t* __restrict__ WT, int ldd, int koff, const float* __restrict__ scale, LAS float* scr, int item, int lane) {
    const int nblk = N / 32, kb = item / nblk, nb = item % nblk, k0 = 64 * kb, n0 = 32 * nb;
    float wv_[32];
    const float* wp_ = W + (size_t)(k0 + (lane >> 5)) * N + n0 + (lane & 31);
#pragma unroll
    for (int i = 0; i < 32; ++i) wv_[i] = __builtin_nontemporal_load(wp_ + (size_t)(2 * i) * N);
    const float sc0 = scale ? scale[k0 + (lane & 31) * 2] : 1.0f, sc1 = scale ? scale[k0 + (lane & 31) * 2 + 1] : 1.0f;
#pragma unroll
    for (int i = 0; i < 32; ++i) { const float se = __shfl(sc0, i), so = __shfl(sc1, i); scr[(2 * i + (lane >> 5)) * 33 + (lane & 31)] = wv_[i] * ((lane >> 5) ? so : se); }
    asm volatile("s_waitcnt lgkmcnt(0)" ::: "memory");
    const int c = lane & 7;
#pragma unroll
    for (int j = 0; j < 4; ++j) { const int n = (lane >> 3) + 8 * j; const LAS float* s = scr + (8 * c) * 33 + n;
        u32x4 o; o.x = pk2(s[0 * 33], s[1 * 33]); o.y = pk2(s[2 * 33], s[3 * 33]); o.z = pk2(s[4 * 33], s[5 * 33]); o.w = pk2(s[6 * 33], s[7 * 33]);
        *(u32x4*)(WT + (size_t)(n0 + n) * ldd + koff + k0 + 8 * c) = o; }
    asm volatile("s_waitcnt lgkmcnt(0)" ::: "memory");
}
struct ConvArgs { const float *w_in, *g_mix, *w_a, *w_b, *w_c, *w_d, *d_scale, *w_o, *w_ff1, *g_ff, *w_ff2; bf16_t *WinT, *WoutT, *WoT, *W1T, *W2T; };
__device__ __forceinline__ void ph_convert(const ConvArgs& a, LAS float* scr, int gw, int ngw, int lane) {
    constexpr int I_IN = (C::D / 64) * (C::DIN / 32), I_OUT = (256 / 64) * (C::D / 32), I_O = (C::D / 64) * (C::D / 32), I_1 = (C::D / 64) * (C::DFF / 32), I_2 = (C::DFF / 64) * (C::D / 32);
    constexpr int NITEMS = I_IN + 4 * I_OUT + I_O + I_1 + I_2;
    for (int it = gw; it < NITEMS; it += ngw) {
        int r = it;
        if (r < I_IN) { transpose_item(a.w_in, C::D, C::DIN, a.WinT, C::D, 0, a.g_mix, scr, r, lane); continue; } r -= I_IN;
        if (r < I_OUT) { transpose_item(a.w_a, 256, C::D, a.WoutT, C::D, 0, nullptr, scr, r, lane); continue; } r -= I_OUT;
        if (r < I_OUT) { transpose_item(a.w_b, 256, C::D, a.WoutT, C::D, 256, nullptr, scr, r, lane); continue; } r -= I_OUT;
        if (r < I_OUT) { transpose_item(a.w_c, 256, C::D, a.WoutT, C::D, 512, nullptr, scr, r, lane); continue; } r -= I_OUT;
        if (r < I_OUT) { transpose_item(a.w_d, 256, C::D, a.WoutT, C::D, 768, a.d_scale, scr, r, lane); continue; } r -= I_OUT;
        if (r < I_O) { transpose_item(a.w_o, C::D, C::D, a.WoT, C::D, 0, nullptr, scr, r, lane); continue; } r -= I_O;
        if (r < I_1) { transpose_item(a.w_ff1, C::D, C::DFF, a.W1T, C::D, 0, a.g_ff, scr, r, lane); continue; } r -= I_1;
        transpose_item(a.w_ff2, C::DFF, C::D, a.W2T, C::DFF, 0, nullptr, scr, r, lane);
    }
}
typedef float f32x16 __attribute__((ext_vector_type(16)));
typedef short v4i16_t __attribute__((ext_vector_type(4)));
__device__ __forceinline__ v4i16_t lds_tr16(LAS unsigned char* p) { return __builtin_amdgcn_ds_read_tr16_b64_v4i16((LAS v4i16_t*)p); }
__device__ __forceinline__ unsigned cvtpk(float lo, float hi) { return pk2(lo, hi); }
constexpr int ATT_VSTRIDE = 192, ATT_KSTRIDE = 144, ATT_KOFF = 32 * ATT_VSTRIDE, ATT_WAVE_LDS = ATT_KOFF + 32 * ATT_KSTRIDE;
__host__ __device__ constexpr int att_lpad(int g) { return g == 0 ? 96 : (g == 1 ? 160 : 64); }
__host__ __device__ constexpr int att_lsize(int g) { return 2 * att_lpad(g) + 160; }
__host__ __device__ constexpr int att_lshift(int g) { return g == 1 ? 5 : 30; }
__host__ __device__ constexpr int att_lphys(int g) { return att_lsize(g) + (att_lsize(g) >> att_lshift(g)) + 1; }
__host__ __device__ constexpr int att_lbase(int g) { return g == 0 ? 0 : (g == 1 ? att_lphys(0) : att_lphys(0) + att_lphys(1)); }
constexpr int ATT_LUT_BYTES = 4864, ATT_XS = 136, ATT_XA_OFF = ATT_LUT_BYTES, ATT_XL_OFF = ATT_XA_OFF + 256 * ATT_XS, ATT_W_OFF = ATT_XL_OFF + 1024;
static_assert(4 * (att_lbase(2) + att_lphys(2)) <= ATT_LUT_BYTES && ATT_W_OFF + 8 * ATT_WAVE_LDS <= 131072, "attention LDS");
__device__ __forceinline__ void ph_attn(const bf16_t* __restrict__ Z, const float* __restrict__ rel_bias, bf16_t* __restrict__ MIX, LAS unsigned char* lds, int wgi, int nwg, int tid, int wv) {
    const int lane = tid & 63, ql = lane & 31, hi = lane >> 5;
    LAS float* lut = (LAS float*)lds; LAS unsigned char* wlds = lds + ATT_W_OFF + wv * ATT_WAVE_LDS;
    LAS unsigned char* xa = lds + ATT_XA_OFF; LAS float* xl = (LAS float*)(lds + ATT_XL_OFF);
    const int tr_off = (4 * hi + ((lane & 15) >> 2)) * ATT_VSTRIDE + (((lane >> 4) & 1) * 16 + (lane & 3) * 4) * 2;
    for (int item = wgi; item < C::NB * 4 * 8; item += nwg) {
        const int bh = item >> 3, b = bh >> 2, hh = bh & 3, J = (item >> 1) & 3, h8 = item & 1;
        const size_t rowb = (size_t)b * C::S;
        __syncthreads();
        for (int i = tid; i < att_lsize(0) + att_lsize(1) + att_lsize(2); i += 512) {
            const int g = i < att_lsize(0) ? 0 : (i < att_lsize(0) + att_lsize(1) ? 1 : 2);
            const int li = i - (g == 0 ? 0 : (g == 1 ? att_lsize(0) : att_lsize(0) + att_lsize(1)));
            const int dl = li - (g == 0 ? att_lpad(0) : (g == 1 ? att_lpad(1) : att_lpad(2)));
            float v = -INFINITY;
            if (dl >= 0 && dl <= 128) v = rel_bias[t5_bucket(dl << (2 * g)) * 12 + g * 4 + hh] * 1.4426950408889634f;
            lut[(g == 0 ? att_lbase(0) : (g == 1 ? att_lbase(1) : att_lbase(2))) + li + (li >> (g == 0 ? att_lshift(0) : (g == 1 ? att_lshift(1) : att_lshift(2))))] = v;
        }
        __syncthreads();
        const int tqA = 512 * J + 16 * (4 * wv + (ql >> 3)) + 8 * h8 + (ql & 7), tA0 = 512 * J + 64 * wv + 8 * h8;
        const int t0 = 512 * J + 8 * h8 + wv, tqB = t0 + 16 * ql;
        const int tlA = (4 * wv + (ql >> 3)) * 8 + (ql & 7), tlB = ql * 8 + wv;
#pragma unroll 1
        for (int pass = 0; pass < 2; ++pass) {
            const int tq = pass == 0 ? tqA : tqB;
            float m_run = -1e30f, l_run = 0.f;
            f32x16 o0, o1;
#pragma unroll
            for (int r = 0; r < 16; ++r) { o0[r] = 0.f; o1[r] = 0.f; }
            bf16x8 qf[4], k1[4], v1[4];
#define ATT_LOADT(KN, VN, gg, kkt) do { const int ssh_ = 2 * (gg); const int rg_ = t0 & ((1 << ssh_) - 1); \
                _Pragma("unroll") for (int i_ = 0; i_ < 4; ++i_) { const int c_ = lane + 64 * i_; \
                    const bf16_t* rp_ = Z + (rowb + (size_t)((((kkt) * 32 + (c_ >> 3)) << ssh_) + rg_)) * 2304 + (gg) * 256 + hh * 64 + (c_ & 7) * 8; \
                    KN[i_] = *(const bf16x8*)(rp_ + 768); VN[i_] = *(const bf16x8*)(rp_ + 1536); } } while (0)
#define ATT_LOADQ(gg) do { const bf16_t* qp_ = Z + (rowb + (size_t)tq) * 2304 + (gg) * 256 + hh * 64 + 8 * hi; \
                _Pragma("unroll") for (int s_ = 0; s_ < 4; ++s_) qf[s_] = *(const bf16x8*)(qp_ + 16 * s_); } while (0)
#define ATT_MQ0(gg) ((gg) == 0 ? tA0 : (t0 >> (2 * (gg))))
#define ATT_SPAN(gg) ((gg) == 0 ? 55 : 31 * (16 >> (2 * (gg))))
#define ATT_KLO(gg) (((ATT_MQ0(gg) - 128) > 0 ? (ATT_MQ0(gg) - 128) : 0) >> 5)
#define ATT_KHI(gg) ((ATT_MQ0(gg) + ATT_SPAN(gg)) >> 5)
            const int gend = pass == 0 ? 1 : 3;
#define ATT_NEXT(gv, kv) do { if ((gv) < gend) { if ((kv) < ATT_KHI(gv)) ++(kv); else { ++(gv); if ((gv) < gend) (kv) = ATT_KLO(gv); } } } while (0)
            int g0_ = pass == 0 ? 0 : 1, kt0_ = ATT_KLO(g0_);
            int qg = g0_;
            ATT_LOADQ(qg);
            ATT_LOADT(k1, v1, g0_, kt0_);
            for (;;) {
                bf16x8 kf[4], vr[4];
#pragma unroll
                for (int s = 0; s < 4; ++s) { kf[s] = k1[s]; vr[s] = v1[s]; }
                const int cg = g0_, csh = 2 * g0_, ckt = kt0_;
                ATT_NEXT(g0_, kt0_);
                const bool more = g0_ < gend;
                asm volatile("s_waitcnt lgkmcnt(0)" ::: "memory");
#pragma unroll
                for (int i = 0; i < 4; ++i) { const int c = lane + 64 * i; *(LAS bf16x8*)(wlds + (c >> 3) * ATT_VSTRIDE + (c & 7) * 16) = vr[i]; *(LAS bf16x8*)(wlds + ATT_KOFF + (c >> 3) * ATT_KSTRIDE + (c & 7) * 16) = kf[i]; }
                if (more) ATT_LOADT(k1, v1, g0_, kt0_);
                asm volatile("s_waitcnt lgkmcnt(0)" ::: "memory");
                const int mq = tq >> csh;
                const int dtop = mq - (ckt * 32 + 4 * hi) - 27;
                const LAS float* lg = lut + (cg == 0 ? att_lbase(0) : (cg == 1 ? att_lbase(1) : att_lbase(2)));
                const int li0 = dtop + (cg == 0 ? att_lpad(0) : (cg == 1 ? att_lpad(1) : att_lpad(2))), lsh = cg == 0 ? att_lshift(0) : (cg == 1 ? att_lshift(1) : att_lshift(2));
                bf16x8 ka[4]; float bia[16]; v4i16_t av[2][4];
#pragma unroll
                for (int s = 0; s < 4; ++s) ka[s] = *(const LAS bf16x8*)(wlds + ATT_KOFF + ql * ATT_KSTRIDE + 32 * s + 16 * hi);
#pragma unroll
                for (int r = 0; r < 16; ++r) { const int li = li0 + 27 - ((r & 3) + 8 * (r >> 2)); bia[r] = lg[li + (li >> lsh)]; }
#pragma unroll
                for (int dt = 0; dt < 2; ++dt)
#pragma unroll
                    for (int j = 0; j < 4; ++j) av[dt][j] = lds_tr16(wlds + tr_off + dt * 64 + 8 * j * ATT_VSTRIDE);
                __builtin_amdgcn_sched_barrier(0);
                f32x16 sacc;
#pragma unroll
                for (int r = 0; r < 16; ++r) sacc[r] = 0.f;
#pragma unroll
                for (int s = 0; s < 4; ++s) sacc = __builtin_amdgcn_mfma_f32_32x32x16_bf16(ka[s], qf[s], sacc, 0, 0, 0);
                if (more && g0_ != qg) { qg = g0_; ATT_LOADQ(qg); }
                float mx = -INFINITY;
#pragma unroll
                for (int r = 0; r < 16; ++r) { sacc[r] += bia[r]; mx = fmaxf(mx, sacc[r]); }
                mx = half_max(mx);
                if (__any(mx > m_run)) {
                    const float m_new = fmaxf(m_run, mx), f = __builtin_amdgcn_exp2f(m_run - m_new);
                    m_run = m_new; l_run *= f;
#pragma unroll
                    for (int r = 0; r < 16; ++r) { o0[r] *= f; o1[r] *= f; }
                }
                float ps = 0.f;
#pragma unroll
                for (int r = 0; r < 16; ++r) { sacc[r] = __builtin_amdgcn_exp2f(sacc[r] - m_run); ps += sacc[r]; }
                l_run += ps;
                u32x4 pw0, pw1;
                pw0.x = cvtpk(sacc[0], sacc[1]); pw0.y = cvtpk(sacc[2], sacc[3]); pw0.z = cvtpk(sacc[4], sacc[5]); pw0.w = cvtpk(sacc[6], sacc[7]);
                pw1.x = cvtpk(sacc[8], sacc[9]); pw1.y = cvtpk(sacc[10], sacc[11]); pw1.z = cvtpk(sacc[12], sacc[13]); pw1.w = cvtpk(sacc[14], sacc[15]);
                const bf16x8 pb0 = __builtin_bit_cast(bf16x8, pw0), pb1 = __builtin_bit_cast(bf16x8, pw1);
                {
                    const bf16x8 va00 = (bf16x8){av[0][0][0], av[0][0][1], av[0][0][2], av[0][0][3], av[0][1][0], av[0][1][1], av[0][1][2], av[0][1][3]};
                    const bf16x8 va01 = (bf16x8){av[0][2][0], av[0][2][1], av[0][2][2], av[0][2][3], av[0][3][0], av[0][3][1], av[0][3][2], av[0][3][3]};
                    const bf16x8 va10 = (bf16x8){av[1][0][0], av[1][0][1], av[1][0][2], av[1][0][3], av[1][1][0], av[1][1][1], av[1][1][2], av[1][1][3]};
                    const bf16x8 va11 = (bf16x8){av[1][2][0], av[1][2][1], av[1][2][2], av[1][2][3], av[1][3][0], av[1][3][1], av[1][3][2], av[1][3][3]};
                    o0 = __builtin_amdgcn_mfma_f32_32x32x16_bf16(va00, pb0, o0, 0, 0, 0); o1 = __builtin_amdgcn_mfma_f32_32x32x16_bf16(va10, pb0, o1, 0, 0, 0);
                    o0 = __builtin_amdgcn_mfma_f32_32x32x16_bf16(va01, pb1, o0, 0, 0, 0); o1 = __builtin_amdgcn_mfma_f32_32x32x16_bf16(va11, pb1, o1, 0, 0, 0);
                }
                if (!more) break;
            }
#undef ATT_LOADT
#undef ATT_LOADQ
#undef ATT_MQ0
#undef ATT_SPAN
#undef ATT_KLO
#undef ATT_KHI
#undef ATT_NEXT
            const float lt = half_sum(l_run);
            if (pass == 0) {
                const float inv = 1.0f / lt;
                LAS unsigned char* xr = xa + tlA * ATT_XS + 8 * hi;
#pragma unroll
                for (int c4 = 0; c4 < 4; ++c4) {
                    u32x2 w0, w1;
                    w0.x = cvtpk(o0[4 * c4] * inv, o0[4 * c4 + 1] * inv); w0.y = cvtpk(o0[4 * c4 + 2] * inv, o0[4 * c4 + 3] * inv);
                    w1.x = cvtpk(o1[4 * c4] * inv, o1[4 * c4 + 1] * inv); w1.y = cvtpk(o1[4 * c4 + 2] * inv, o1[4 * c4 + 3] * inv);
                    *(LAS u32x2*)(xr + 16 * c4) = w0; *(LAS u32x2*)(xr + 64 + 16 * c4) = w1;
                }
                if (hi == 0) xl[tlA] = m_run + __builtin_amdgcn_logf(lt);
                __syncthreads();
            } else {
                const float la = xl[tlB], M = fmaxf(la, m_run), wa = __builtin_amdgcn_exp2f(la - M), wb = __builtin_amdgcn_exp2f(m_run - M), inv = 1.0f / (wa + wb * lt);
                const float ca = wa * inv, cb = wb * inv;
                const LAS unsigned char* xr = xa + tlB * ATT_XS + 8 * hi;
                bf16_t* op = MIX + (rowb + (size_t)tqB) * C::D + 512 + hh * 64 + 4 * hi;
#pragma unroll
                for (int c4 = 0; c4 < 4; ++c4) {
                    const u32x2 a0 = *(const LAS u32x2*)(xr + 16 * c4), a1 = *(const LAS u32x2*)(xr + 64 + 16 * c4);
                    u32x2 w0, w1;
                    w0.x = cvtpk(ca * __uint_as_float(a0.x << 16) + cb * o0[4 * c4], ca * __uint_as_float(a0.x & 0xffff0000u) + cb * o0[4 * c4 + 1]);
                    w0.y = cvtpk(ca * __uint_as_float(a0.y << 16) + cb * o0[4 * c4 + 2], ca * __uint_as_float(a0.y & 0xffff0000u) + cb * o0[4 * c4 + 3]);
                    w1.x = cvtpk(ca * __uint_as_float(a1.x << 16) + cb * o1[4 * c4], ca * __uint_as_float(a1.x & 0xffff0000u) + cb * o1[4 * c4 + 1]);
                    w1.y = cvtpk(ca * __uint_as_float(a1.y << 16) + cb * o1[4 * c4 + 2], ca * __uint_as_float(a1.y & 0xffff0000u) + cb * o1[4 * c4 + 3]);
                    *(u32x2*)(op + 8 * c4) = w0; *(u32x2*)(op + 32 + 8 * c4) = w1;
                }
            }
        }
    }
}
constexpr int MA_VS = 272;
__device__ __forceinline__ void ph_mixA(const bf16_t* __restrict__ ZA, const float* __restrict__ ln_g, const float* __restrict__ ln_b, const bf16_t* __restrict__ WSB, const float* __restrict__ WSUM, const float* __restrict__ bs,
                                        bf16_t* __restrict__ MIX, LAS unsigned char* lds, int wg, int nwg, int tid, int wv) {
    const int lane = tid & 63, fr = lane & 15, fq = lane >> 4;
    for (int item = wg; item < C::T / 64; item += nwg) {
        const int t0 = (item >> 1) * 128, h = item & 1;
        const int gl = wv >> 2, tq = wv & 3, g = 2 * h + gl;
        bf16x8 bfr[2][4]; u32x2 urv[2][4]; f32x4 lgv[4], lbv[4]; float bsv[2], wsum[2];
#pragma unroll
        for (int i = 0; i < 2; ++i) { const int tb = 16 * (tq + 4 * i), nks = ((tb + 15) >> 5) + 1;
#pragma unroll
            for (int ks = 0; ks < 4; ++ks) if (ks < nks) bfr[i][ks] = *(const bf16x8*)(WSB + ((size_t)(g * 128 + tb + fr) * 128 + 32 * ks + 8 * fq));
#pragma unroll
            for (int cb = 0; cb < 4; ++cb) urv[i][cb] = *(const u32x2*)(ZA + (size_t)(t0 + tb + fr) * 512 + g * 64 + cb * 16 + fq * 4);
            bsv[i] = bs[g * 128 + tb + fr]; wsum[i] = WSUM[g * 128 + tb + fr]; }
#pragma unroll
        for (int cb = 0; cb < 4; ++cb) { lgv[cb] = *(const f32x4*)(ln_g + g * 64 + cb * 16 + fq * 4); lbv[cb] = *(const f32x4*)(ln_b + g * 64 + cb * 16 + fq * 4); }
        __syncthreads();
        {
            const int s = tid >> 2, q = tid & 3;
            const u32x4* src = (const u32x4*)(ZA + (size_t)(t0 + s) * 512 + 256 + 64 * q);
            u32x4 raw[8]; float sum = 0.f, sq = 0.f;
#pragma unroll
            for (int i = 0; i < 8; ++i) raw[i] = src[i];
#pragma unroll
            for (int i = 0; i < 8; ++i)
#pragma unroll
                for (int e = 0; e < 4; ++e) { const float a = __uint_as_float(raw[i][e] << 16), b = __uint_as_float(raw[i][e] & 0xffff0000u); sum += a + b; sq += a * a + b * b; }
            sum += swz_xor<1>(sum); sq += swz_xor<1>(sq); sum += swz_xor<2>(sum); sq += swz_xor<2>(sq);
            const float mu = sum * (1.0f / 256.0f), var = fmaxf(sq * (1.0f / 256.0f) - mu * mu, 0.f), rs = rsqrtf(var + C::EPS);
            if ((q >> 1) == h) {
                LAS u32x4* dst = (LAS u32x4*)(lds + s * MA_VS + (q & 1) * 128);
#pragma unroll
                for (int i = 0; i < 8; ++i) { u32x4 w;
#pragma unroll
                    for (int e = 0; e < 4; ++e) w[e] = pk2((__uint_as_float(raw[i][e] << 16) - mu) * rs, (__uint_as_float(raw[i][e] & 0xffff0000u) - mu) * rs);
                    dst[i] = w; }
            }
        }
        __syncthreads();
        LAS unsigned char* trb = lds + (8 * fq + ((lane & 15) >> 2)) * MA_VS + (gl * 64 + (lane & 3) * 4) * 2;
#pragma unroll
        for (int i = 0; i < 2; ++i) {
            const int tb = 16 * (tq + 4 * i), nks = ((tb + 15) >> 5) + 1;
            f32x4 acc[4];
#pragma unroll
            for (int cb = 0; cb < 4; ++cb) acc[cb] = (f32x4){0.f, 0.f, 0.f, 0.f};
#pragma unroll
            for (int ks = 0; ks < 4; ++ks) if (ks < nks) {
#pragma unroll
                for (int cb = 0; cb < 4; ++cb) {
                    const v4i16_t a0 = lds_tr16(trb + ks * 32 * MA_VS + cb * 32), a1 = lds_tr16(trb + (ks * 32 + 4) * MA_VS + cb * 32);
                    const bf16x8 a = (bf16x8){a0[0], a0[1], a0[2], a0[3], a1[0], a1[1], a1[2], a1[3]};
                    acc[cb] = __builtin_amdgcn_mfma_f32_16x16x32_bf16(a, bfr[i][ks], acc[cb], 0, 0, 0);
                }
            }
            const int t = tb + fr;
#pragma unroll
            for (int cb = 0; cb < 4; ++cb) {
                const int ch = g * 64 + cb * 16 + fq * 4;
                const u32x2 ur = urv[i][cb];
                const float u0 = __uint_as_float(ur.x << 16), u1 = __uint_as_float(ur.x & 0xffff0000u), u2 = __uint_as_float(ur.y << 16), u3 = __uint_as_float(ur.y & 0xffff0000u);
                u32x2 w; w.x = pk2(u0 * (lgv[cb][0] * acc[cb][0] + lbv[cb][0] * wsum[i] + bsv[i]), u1 * (lgv[cb][1] * acc[cb][1] + lbv[cb][1] * wsum[i] + bsv[i])); w.y = pk2(u2 * (lgv[cb][2] * acc[cb][2] + lbv[cb][2] * wsum[i] + bsv[i]), u3 * (lgv[cb][3] * acc[cb][3] + lbv[cb][3] * wsum[i] + bsv[i]));
                *(u32x2*)(MIX + (size_t)(t0 + t) * C::D + ch) = w;
            }
        }
    }
    __syncthreads();
}
__device__ __forceinline__ void ph_mixB(const bf16_t* __restrict__ ZB, const float* __restrict__ cw, bf16_t* __restrict__ MIX, int gt, int ngt) {
    for (int idx = gt; idx < C::T * 32; idx += ngt) {
        const int t = idx >> 5, ch = (idx & 31) * 8, s = t & (C::S - 1);
        float acc[8];
#pragma unroll
        for (int e = 0; e < 8; ++e) acc[e] = 0.f;
#pragma unroll
        for (int j = 0; j < 3; ++j) {
            if (s + j - 2 >= 0) {
                const bf16_t* p = ZB + (size_t)(t + j - 2) * 768 + ch;
                const u32x4 cv = *(const u32x4*)(p + 256), xv = *(const u32x4*)(p + 512);
                const f32x4 w0 = *(const f32x4*)(cw + j * 256 + ch), w1 = *(const f32x4*)(cw + j * 256 + ch + 4);
#pragma unroll
                for (int e = 0; e < 4; ++e) {
                    acc[2 * e] += (e < 2 ? w0[2 * e] : w1[2 * e - 4]) * (__uint_as_float(cv[e] << 16) * __uint_as_float(xv[e] << 16));
                    acc[2 * e + 1] += (e < 2 ? w0[2 * e + 1] : w1[2 * e - 3]) * (__uint_as_float(cv[e] & 0xffff0000u) * __uint_as_float(xv[e] & 0xffff0000u));
                }
            }
        }
        const u32x4 bv = *(const u32x4*)(ZB + (size_t)t * 768 + ch);
        u32x4 o;
#pragma unroll
        for (int e = 0; e < 4; ++e) o[e] = pk2(__uint_as_float(bv[e] << 16) * acc[2 * e], __uint_as_float(bv[e] & 0xffff0000u) * acc[2 * e + 1]);
        *(u32x4*)(MIX + (size_t)t * C::D + 256 + ch) = o;
    }
}
constexpr int MD_RS = 144, MD_WAVE_LDS = 32 * MD_RS;
template <int GI> __device__ __forceinline__ void mixD_items(const bf16_t* __restrict__ ZD, const bf16_t* __restrict__ DWT, bf16_t* __restrict__ MIX, LAS unsigned char* wl, int blk0, int nblk, int lane) {
    constexpr int W = 2 << GI;
    const int fr = lane & 15, fq = lane >> 4;
    bf16x8 af[4][2];
#pragma unroll
    for (int eb = 0; eb < 4; ++eb)
#pragma unroll
        for (int ks = 0; ks < 2; ++ks) af[eb][ks] = *(const bf16x8*)(DWT + ((size_t)(GI * 64 + eb * 16 + fr) * 64 + 32 * ks + 8 * fq));
#define MD_LOAD(dst, bb) do { const int tb_ = (bb) * 16, sb_ = tb_ & (C::S - 1); _Pragma("unroll") for (int i = 0; i < 4; ++i) { const int c = lane + 64 * i, j = c >> 3; const int jj = j < 31 ? j : 30; \
        const int off = (sb_ - 15 + jj < 0) ? -sb_ : (jj - 15); dst[i] = *(const u32x4*)(ZD + (size_t)(tb_ + off) * 256 + GI * 64 + (c & 7) * 8); } } while (0)
    u32x4 nx[4];
    if (blk0 < C::T / 16) MD_LOAD(nx, blk0);
    for (int blk = blk0; blk < C::T / 16; blk += nblk) {
        const int tb = blk * 16, sb = tb & (C::S - 1);
        u32x4 cur[4];
#pragma unroll
        for (int i = 0; i < 4; ++i) cur[i] = nx[i];
        if (blk + nblk < C::T / 16) MD_LOAD(nx, blk + nblk);
        asm volatile("s_waitcnt lgkmcnt(0)" ::: "memory");
#pragma unroll
        for (int i = 0; i < 4; ++i) { const int c = lane + 64 * i, j = c >> 3; if (j < 31) *(LAS u32x4*)(wl + j * MD_RS + (c & 7) * 16) = cur[i]; }
        asm volatile("s_waitcnt lgkmcnt(0)" ::: "memory");
        const int s = sb + fr, cnt = (s + 1 < W) ? s + 1 : W; const float inv = 1.0f / (float)cnt;
        bf16x8 yb[2];
#pragma unroll
        for (int ks = 0; ks < 2; ++ks) {
            u32x4 zv[W];
#pragma unroll
            for (int j = 0; j < W; ++j) zv[j] = *(const LAS u32x4*)(wl + (15 + fr - j) * MD_RS + (4 * ks + fq) * 16);
            float sum[8];
#pragma unroll
            for (int e = 0; e < 8; ++e) sum[e] = 0.f;
#pragma unroll
            for (int j = 0; j < W; ++j) { const float wj = j < cnt ? 1.0f : 0.0f;
#pragma unroll
                for (int e = 0; e < 4; ++e) { sum[2 * e] += wj * __uint_as_float(zv[j][e] << 16); sum[2 * e + 1] += wj * __uint_as_float(zv[j][e] & 0xffff0000u); } }
            u32x4 yw;
#pragma unroll
            for (int e = 0; e < 4; ++e) yw[e] = pk2(sum[2 * e] * inv - __uint_as_float(zv[0][e] << 16), sum[2 * e + 1] * inv - __uint_as_float(zv[0][e] & 0xffff0000u));
            yb[ks] = __builtin_bit_cast(bf16x8, yw);
        }
#pragma unroll
        for (int eb = 0; eb < 4; ++eb) {
            f32x4 acc = (f32x4){0.f, 0.f, 0.f, 0.f};
            acc = __builtin_amdgcn_mfma_f32_16x16x32_bf16(af[eb][0], yb[0], acc, 0, 0, 0);
            acc = __builtin_amdgcn_mfma_f32_16x16x32_bf16(af[eb][1], yb[1], acc, 0, 0, 0);
            u32x2 o; o.x = pk2(acc[0], acc[1]); o.y = pk2(acc[2], acc[3]);
            *(u32x2*)(MIX + (size_t)(tb + fr) * C::D + 768 + GI * 64 + eb * 16 + fq * 4) = o;
        }
    }
#undef MD_LOAD
}
__device__ __forceinline__ void ph_mixD(const bf16_t* __restrict__ ZD, const bf16_t* __restrict__ DWT, bf16_t* __restrict__ MIX, LAS unsigned char* wl, int gw, int ngw, int lane) {
    const int gi = gw & 3, blk0 = gw >> 2, nblk = ngw >> 2;
    if (gi == 0) mixD_items<0>(ZD, DWT, MIX, wl, blk0, nblk, lane);
    else if (gi == 1) mixD_items<1>(ZD, DWT, MIX, wl, blk0, nblk, lane);
    else if (gi == 2) mixD_items<2>(ZD, DWT, MIX, wl, blk0, nblk, lane);
    else mixD_items<3>(ZD, DWT, MIX, wl, blk0, nblk, lane);
}
__device__ __forceinline__ void ph_convert_small(const float* __restrict__ a_ws, const float* __restrict__ d_w, bf16_t* __restrict__ WSB, bf16_t* __restrict__ DWT, float* __restrict__ WSUM, int gt, int ngt) {
    for (int i = gt; i < 4 * 128; i += ngt) { const float* wr_ = a_ws + (size_t)i * 128; const int t = i & 127; float a = 0.f; for (int s = 0; s <= t; ++s) a += bf2f((unsigned short)f2bf(wr_[s])); WSUM[i] = a; }
    for (int i = gt; i < 4 * 128 * 128; i += ngt) { const int s = i & 127, t = (i >> 7) & 127; WSB[i] = (bf16_t)(s <= t ? f2bf(a_ws[i]) : 0u); }
    for (int i = gt; i < 4 * 64 * 64; i += ngt) { const int d = i & 63, e = (i >> 6) & 63, gi = i >> 12; DWT[i] = (bf16_t)f2bf(d_w[(gi * 64 + d) * 64 + e]); }
}
__device__ __forceinline__ void build_rstd_table(const float* __restrict__ SSQ, int pm, LAS float* rtab, int tid) {
    const int r = tid >> 1, h = tid & 1;
    const f32x4* p = (const f32x4*)(SSQ + (size_t)(pm * 256 + r) * 16 + h * 8); const f32x4 a = p[0], b = p[1];
    float s = ((a.x + a.y) + (a.z + a.w)) + ((b.x + b.y) + (b.z + b.w));
    s += swz_xor<1>(s);
    if (h == 0) rtab[r] = rsqrtf(s * (1.0f / C::D) + C::EPS);
    __syncthreads();
}

__device__ __forceinline__ bool runs_phase(int lo, int hi, int k) { asm volatile("" : "+s"(lo), "+s"(hi)); return lo <= k && k < hi; }
constexpr int NPHASES = 19;
#ifndef PROBE_DUP_PHASE
#define PROBE_DUP_PHASE -1
#endif
#define NREP(kind) ((kind) == PROBE_DUP_PHASE ? 2 : 1)
struct Args { const float* in[20]; float* out; unsigned char* ws; int ph_lo, ph_hi, li, pad; };
__global__ void __launch_bounds__(512, 2) mk_fwd(Args args) {
    extern __shared__ __attribute__((aligned(16))) unsigned char lds_raw[];
    LAS unsigned char* lds = (LAS unsigned char*)lds_raw;
    const int tid0 = threadIdx.x, wave = __builtin_amdgcn_readfirstlane(tid0 >> 6);
    constexpr int G = 256;
    const int bx = blockIdx.x, vcu0 = (bx % 8) * (G / 8) + bx / 8;
    constexpr int ngw = G * 8, ngt = G * 512;
    unsigned char* ws = args.ws;
    unsigned* ctl = (unsigned*)(ws + C::WS_CTL);
    for (int u = tid0; u < (C::LDS_BYTES - C::LDSCTL_OFF) / 4; u += 512) ((LAS unsigned*)(lds + C::LDSCTL_OFF))[u] = 0u;
    __syncthreads();
    volatile LAS unsigned* MISC = (volatile LAS unsigned*)(lds + C::MISC_OFF);
    XcdBarrier bar = xcd_barrier_post(ctl + C::CW_BAR + args.li * XCD_BAR_WORDS, MISC + 8);
    const int lo = args.ph_lo, hi = args.ph_hi;

    LAS float* scr = (LAS float*)(lds + wave * 16384);
    float* X = args.out;
    float* const WSC = (float*)((unsigned char*)args.out + C::OUT_WSC); float* const XS = WSC + 16384;   unsigned char* const XQ = (unsigned char*)args.out + C::OUT_XQ; unsigned char* const WGQ = (unsigned char*)args.out + C::OUT_WGQ;
    bf16_t* const W2T_L1 = (bf16_t*)((unsigned char*)args.out + 32 * C::MiB);
    int p = 0;
#define RUNS(k) runs_phase(lo, hi, (k))
#define SEAM(k) do { if ((k) + 1 < hi) { xcd_barrier(bar); if (NREP(50) == 2) xcd_barrier(bar); } } while (0)
#define PHASE_BEGIN int lane; asm volatile("v_mbcnt_lo_u32_b32 %0, -1, 0\n\tv_mbcnt_hi_u32_b32 %0, -1, %0" : "=v"(lane)); int vcu = vcu0; asm volatile("" : "+s"(vcu)); const int tid = wave * 64 + lane, gt = vcu * 512 + tid, gw = vcu * 8 + wave; (void)gt; (void)gw; \
    GAS unsigned char* wsg_ = (GAS unsigned char*)ws; asm volatile("" : "+s"(wsg_)); unsigned char* wsp = (unsigned char*)wsg_; (void)wsp
#define P_SSQ ((float*)(wsp + C::WS_SSQ))
#define P_WINT ((bf16_t*)(wsp + C::WS_WIN))
#define P_WOUTT ((bf16_t*)(wsp + C::WS_WOUT))
#define P_WOT ((bf16_t*)(wsp + C::WS_WO))
#define P_W1T ((bf16_t*)(wsp + C::WS_W1))
#define P_W2T ((bf16_t*)(wsp + C::WS_W2))
#define P_XB ((bf16_t*)(wsp + C::WS_XB))
#define P_MIX ((bf16_t*)X)
#define P_ZA ((bf16_t*)(wsp + C::WS_ZA))
#define P_ZB ((bf16_t*)(wsp + C::WS_ZB))
#define P_ZQKV ((bf16_t*)(wsp + C::WS_ZQKV))
#define P_ZD ((bf16_t*)(wsp + C::WS_ZD))
#define P_WSB ((bf16_t*)(wsp + C::WS_WSB))
#define P_DWT ((bf16_t*)(wsp + C::WS_DWT))
#define P_WSUM ((float*)(wsp + C::WS_WSUM))
#define P_PART ((float*)(wsp + C::WS_PART))
#define P_G (wsp + C::WS_G)
#define P_MERGED ((bf16_t*)(wsp + C::WS_MERGED))
#define P_H ((bf16_t*)(wsp + C::WS_H))
    for (int l = 0; l < C::L; ++l) {
        if (l == 0 && RUNS(p)) {
            PHASE_BEGIN;
            _Pragma("unroll 1") for (int rep_ = 0; rep_ < NREP(0); ++rep_) {
            if (rep_) xcd_barrier(bar);
            if (l == 0) ph_prologue(args.in[0], P_XB, P_SSQ, XQ, XS, gw, ngw, lane);
            ConvArgs ca{args.in[2] + (size_t)l * C::D * C::DIN, args.in[1] + l * C::D, args.in[7] + (size_t)l * 256 * C::D, args.in[9] + (size_t)l * 256 * C::D, args.in[11] + (size_t)l * 256 * C::D, args.in[14] + (size_t)l * 256 * C::D,
                        args.in[13] + l * 256, args.in[15] + (size_t)l * C::D * C::D, args.in[17] + (size_t)l * C::D * C::DFF, args.in[16] + l * C::D, args.in[18] + (size_t)l * C::DFF * C::D, P_WINT, P_WOUTT, P_WOT, P_W1T, P_W2T};
            ph_convert(ca, scr, gw, ngw, lane);
            ph_convert_small(args.in[5] + (size_t)l * 4 * 128 * 128, args.in[12] + (size_t)l * 4 * 64 * 64, P_WSB, P_DWT, P_WSUM, gt, ngt);
            }
            SEAM(p);
        }
        ++p;
        if (RUNS(p)) {
            PHASE_BEGIN;
            ph_quant(P_WINT, WGQ, (size_t)C::D, WSC, C::I8_N0, C::DIN, P_XB, P_SSQ, XQ, XS, l > 0, gw, ngw, lane);
            if (NREP(70) == 2) { xcd_barrier(bar); PHASE_BEGIN; ph_quant(P_WINT, WGQ, (size_t)C::D, WSC, C::I8_N0, C::DIN, P_XB, P_SSQ, XQ, XS, l > 0, gw, ngw, lane); }
            SEAM(p);
        }
        ++p;
        if (RUNS(p)) {
            PHASE_BEGIN;
            _Pragma("unroll 1") for (int rep_ = 0; rep_ < NREP(1); ++rep_) {
            if (rep_) xcd_barrier(bar);
            {
                pg8::Gemm g{P_XB, P_WINT, C::T, C::I8_N0, C::D, C::D, C::D}; pg8::StaticOrder S; S.init(C::T, C::I8_N0, G, bx);
                pg8::Unit u0; S.next(0, u0); LAS float* rtab = (LAS float*)(lds + C::RTAB_OFF); build_rstd_table(P_SSQ, u0.pm, rtab, tid);
                pg8::PartOrder S8; S8.init(bx, 10);
                { LAS float* ctab = (LAS float*)(lds + C::CTAB_OFF);
                  float cv[8]; float xv = 0.f;
                  _Pragma("unroll") for (int i_ = 0; i_ < 8; ++i_) cv[i_] = (i_ < S8.cnt && tid < 256) ? WSC[C::I8_N0 + S8.tile(i_) * 256 + tid] : 0.f;
                  if (tid < 256) xv = XS[S8.pm * 256 + tid];
                  _Pragma("unroll") for (int i_ = 0; i_ < 8; ++i_) if (i_ < S8.cnt && tid < 256) ctab[i_ * 256 + tid] = cv[i_];
                  if (tid < 256) ((LAS float*)(lds + C::XTAB_OFF))[tid] = xv; }
                pg8::EpiInproj E{P_SSQ, P_ZA, P_ZB, P_ZQKV, P_ZD, P_G, rtab, u0.pm, wsp};
                pg8::gemm_phase<pg8::EpiInproj, pg8::StaticOrder, true, true>(lds, g, S, E, wave);
            }
            {
                pg8::Gemm g{(const bf16_t*)XQ, (const bf16_t*)(WGQ + (size_t)C::I8_N0 * C::D), C::T, C::DIN - C::I8_N0, C::D / 2, C::D / 2, C::D / 2};
                pg8::PartOrder S8; S8.init(bx, 10);
                pg8::EpiInprojI8 E{P_ZA, P_ZB, P_ZQKV, P_ZD, P_G, (const LAS float*)(lds + C::CTAB_OFF), (const LAS float*)(lds + C::XTAB_OFF), wsp, C::I8_N0 / 256, S8.l0, S8.nl, S8.h0};
                pg8::gemm_phase<pg8::EpiInprojI8, pg8::PartOrder, true, true>(lds, g, S8, E, wave);
            }
            }
            SEAM(p);
        }
        ++p;
        if (RUNS(p)) {
            PHASE_BEGIN;
            _Pragma("unroll 1") for (int rep_ = 0; rep_ < NREP(2); ++rep_) {
            if (rep_) xcd_barrier(bar);
            ph_attn(P_ZQKV, args.in[10], P_MIX, lds, vcu, G, tid, wave);
            if (NREP(20) == 2) { PHASE_BEGIN; ph_attn(P_ZQKV, args.in[10], P_MIX, lds, vcu, G, tid, wave); }
            ph_mixB(P_ZB, args.in[8] + l * 3 * 256, P_MIX, gt, ngt);
            if (NREP(21) == 2) { PHASE_BEGIN; ph_mixB(P_ZB, args.in[8] + l * 3 * 256, P_MIX, gt, ngt); }
            ph_mixD(P_ZD, P_DWT, P_MIX, lds + ATT_W_OFF + wave * ATT_WAVE_LDS, gw, ngw, lane);
            if (NREP(22) == 2) { PHASE_BEGIN; ph_mixD(P_ZD, P_DWT, P_MIX, lds + ATT_W_OFF + wave * ATT_WAVE_LDS, gw, ngw, lane); }
            ph_mixA(P_ZA, args.in[3] + l * 256, args.in[4] + l * 256, P_WSB, P_WSUM, args.in[6] + l * 4 * 128, P_MIX, lds, vcu, G, tid, wave);
            if (NREP(23) == 2) { PHASE_BEGIN; ph_mixA(P_ZA, args.in[3] + l * 256, args.in[4] + l * 256, P_WSB, P_WSUM, args.in[6] + l * 4 * 128, P_MIX, lds, vcu, G, tid, wave); }
            }
            SEAM(p);
        }
        ++p;
        if (RUNS(p)) {
            PHASE_BEGIN;
            _Pragma("unroll 1") for (int rep_ = 0; rep_ < NREP(3); ++rep_) {
            if (rep_) xcd_barrier(bar);
            pg8::gemm_merge_phase(lds, P_MIX, P_WOUTT, P_G, P_MERGED, vcu, G, wave);
            }
            SEAM(p);
        }
        ++p;
        if (RUNS(p)) {
            PHASE_BEGIN;
            pg8::Gemm g{P_MERGED, P_WOT, C::T, C::D, C::D, C::D, C::D}; pg8::StaticOrder S; S.init(C::T, C::D, G, bx);
            pg8::EpiResid E{P_XB, P_SSQ};
            pg8::gemm_phase<pg8::EpiResid, pg8::StaticOrder, false, true>(lds, g, S, E, wave);
            if (NREP(4) == 2) { xcd_barrier(bar); PHASE_BEGIN; pg8::Gemm g2{P_MERGED, P_WOT, C::T, C::D, C::D, C::D, C::D}; pg8::EpiResid E2{(bf16_t*)(wsp + 184 * C::MiB), (float*)(wsp + 216 * C::MiB)};
                pg8::gemm_phase<pg8::EpiResid, pg8::StaticOrder, false, true>(lds, g2, S, E2, wave); }
            SEAM(p);
        }
        ++p;
        if (RUNS(p)) {
            PHASE_BEGIN;
            ph_quant(P_W1T, (unsigned char*)P_W1T, (size_t)C::D * 2, WSC + 8192, 0, C::DFF, P_XB, P_SSQ, XQ, XS, true, gw, ngw, lane);
            SEAM(p);
        }
        ++p;
        if (RUNS(p)) {
            PHASE_BEGIN;
            _Pragma("unroll 1") for (int rep_ = 0; rep_ < NREP(5); ++rep_) {
            if (rep_) xcd_barrier(bar);
            pg8::Gemm g{(const bf16_t*)XQ, P_W1T, C::T, C::DFF, C::D / 2, C::D / 2, C::D}; pg8::StaticOrder S; S.init(C::T, C::DFF, G, bx);
            { LAS float* ctab = (LAS float*)(lds + C::CTAB_OFF);
              float cv[4]; int sl[4]; float xv = 0.f; pg8::Unit u0; S.next(0, u0);
              _Pragma("unroll") for (int i_ = 0; i_ < 4; ++i_) { pg8::Unit ui; const bool ok = S.next(i_, ui); sl[i_] = ok ? (ui.pn >> 2) : -1; cv[i_] = (ok && tid < 256) ? WSC[8192 + ui.pn * 256 + tid] : 0.f; }
              if (tid < 256) xv = XS[u0.pm * 256 + tid];
              _Pragma("unroll") for (int i_ = 0; i_ < 4; ++i_) if (sl[i_] >= 0 && tid < 256) ctab[sl[i_] * 256 + tid] = cv[i_];
              if (tid < 256) ((LAS float*)(lds + C::XTAB_OFF))[tid] = xv; }
            __syncthreads();
            pg8::EpiFF1I8 E{P_H, (const LAS float*)(lds + C::CTAB_OFF), (const LAS float*)(lds + C::XTAB_OFF)};
            pg8::gemm_phase<pg8::EpiFF1I8, pg8::StaticOrder, true, true>(lds, g, S, E, wave);
            }
            SEAM(p);
        }
        ++p;
        if (RUNS(p)) {
            PHASE_BEGIN;
            pg8::Gemm g{P_H, l == 0 ? P_W2T : W2T_L1, C::T, C::D, C::DFF, C::DFF, C::DFF}; pg8::StaticOrder S; S.init(C::T, C::D, G, bx);
            pg8::EpiResid E{P_XB, P_SSQ};
            pg8::gemm_phase<pg8::EpiResid, pg8::StaticOrder, false, true>(lds, g, S, E, wave);
            if (l + 1 < C::L) {
                const int l1 = l + 1;
                PHASE_BEGIN;
                ConvArgs ca{args.in[2] + (size_t)l1 * C::D * C::DIN, args.in[1] + l1 * C::D, args.in[7] + (size_t)l1 * 256 * C::D, args.in[9] + (size_t)l1 * 256 * C::D, args.in[11] + (size_t)l1 * 256 * C::D, args.in[14] + (size_t)l1 * 256 * C::D,
                            args.in[13] + l1 * 256, args.in[15] + (size_t)l1 * C::D * C::D, args.in[17] + (size_t)l1 * C::D * C::DFF, args.in[16] + l1 * C::D, args.in[18] + (size_t)l1 * C::DFF * C::D, P_WINT, P_WOUTT, P_WOT, P_W1T, W2T_L1};
                ph_convert(ca, scr, gw, ngw, lane);
                ph_convert_small(args.in[5] + (size_t)l1 * 4 * 128 * 128, args.in[12] + (size_t)l1 * 4 * 64 * 64, P_WSB, P_DWT, P_WSUM, gt, ngt);
            }
            SEAM(p);
        }
        ++p;
    }
    if (RUNS(p)) { PHASE_BEGIN; ph_final(P_XB, X, args.in[19], P_SSQ, gw, ngw, lane); }
#undef RUNS
#undef SEAM
}

extern "C" void kernel_launch(void* const* d_in, const int* in_sizes, int n_in, void* d_out, int out_size, void* d_ws, size_t ws_size, hipStream_t stream) {
    static int grid = 0;
    if (grid == 0) {
        if (n_in != 20 || out_size != C::T * C::D || ws_size < C::WS_END) { fprintf(stderr, "kernel_launch: unexpected shapes (n_in %d out %d ws %zu)\n", n_in, out_size, ws_size); grid = -1; return; }
        int dev = 0, cus = 0, per_cu = 0;
        if (hipGetDevice(&dev) != hipSuccess || hipDeviceGetAttribute(&cus, hipDeviceAttributeMultiprocessorCount, dev) != hipSuccess) { grid = -1; return; }
        if (hipFuncSetAttribute((const void*)mk_fwd, hipFuncAttributeMaxDynamicSharedMemorySize, C::LDS_BYTES) != hipSuccess) { fprintf(stderr, "kernel_launch: hipFuncSetAttribute failed\n"); grid = -1; return; }
        if (hipOccupancyMaxActiveBlocksPerMultiprocessor(&per_cu, (const void*)mk_fwd, 512, C::LDS_BYTES) != hipSuccess || per_cu < 1) { fprintf(stderr, "kernel_launch: occupancy query says %d blocks per CU\n", per_cu); grid = -1; (void)hipGetLastError(); return; }
        if (cus != 256) { fprintf(stderr, "kernel_launch: built for a 256-CU device, found %d CUs\n", cus); grid = -1; return; }
        grid = cus;
    }
    if (grid < 0) return;
    (void)hipMemsetAsync((char*)d_ws + C::WS_CTL, 0, C::CTL_ZERO_BYTES, stream);
    Args a{};
    for (int i = 0; i < 20; ++i) a.in[i] = (const float*)d_in[i];
    a.out = (float*)d_out; a.ws = (unsigned char*)d_ws;
#ifndef MK_SPLIT
    a.ph_lo = 0; a.ph_hi = NPHASES; a.li = 0;
    hipLaunchKernelGGL(mk_fwd, dim3(grid), dim3(512), C::LDS_BYTES, stream, a);
#else
    for (int p = 0; p < NPHASES; ++p) { a.ph_lo = p; a.ph_hi = p + 1; a.li = p; hipLaunchKernelGGL(mk_fwd, dim3(grid), dim3(512), C::LDS_BYTES, stream, a); }
#endif
}
```

```cpp
#include <hip/hip_runtime.h>
#include <stdint.h>
#include <stdio.h>

namespace C {
constexpr int D = 1024, NB = 8, S = 2048, T = NB * S, L = 2;
constexpr int DIN = 7936, DFF = 4096;
constexpr float EPS = 1e-6f;
constexpr size_t MiB = 1u << 20;
constexpr size_t WS_CTL = 0, CTL_ZERO_BYTES = 256 * 1024;
constexpr size_t WS_SSQ = 1 * MiB;
constexpr size_t WS_WSB = 2 * MiB;
constexpr size_t WS_WSUM = 2 * MiB + 196608;
constexpr size_t WS_DWT = 2 * MiB + 131072;
constexpr size_t WS_WIN = 3 * MiB;
constexpr size_t WS_WOUT = WS_WIN + 15 * MiB + MiB / 2;
constexpr size_t WS_WO = WS_WOUT + 2 * MiB;
constexpr size_t WS_W1 = WS_WO + 2 * MiB;
constexpr size_t WS_W2 = WS_W1 + 8 * MiB;
constexpr size_t WS_XB = 40 * MiB;
constexpr size_t WS_ZA = 72 * MiB;
constexpr size_t WS_ZB = 88 * MiB;
constexpr size_t WS_ZQKV = 112 * MiB;
constexpr size_t WS_ZD = 184 * MiB;
constexpr size_t WS_G = 192 * MiB;
constexpr size_t WS_MERGED = 72 * MiB;
constexpr size_t WS_PART = 112 * MiB;
constexpr size_t WS_H = 112 * MiB;
constexpr size_t WS_END = 256 * MiB;
constexpr int CW_PANEL = 32768;
constexpr int CW_GMAX = 2048;
constexpr int I8_N0 = 1280;
constexpr size_t OUT_W2T1 = 32 * MiB, OUT_XQ = 40 * MiB, OUT_WGQ = 56 * MiB, OUT_WSC = 56 * MiB + (size_t)7936 * 1024;
constexpr int CW_BAR = 4096;
constexpr int RING_BYTES = 131072, LDSCTL_OFF = RING_BYTES, MISC_OFF = LDSCTL_OFF + 320, RTAB_OFF = RING_BYTES + 1024  , CTAB_OFF = RING_BYTES + 2048  , XTAB_OFF = CTAB_OFF + 8192  , LDS_BYTES = CTAB_OFF + 16384;
}
#define LAS __attribute__((address_space(3)))
#define GAS __attribute__((address_space(1)))
__device__ __forceinline__ float bf2f(unsigned short v) { return __uint_as_float((unsigned)v << 16); }
__device__ __forceinline__ unsigned f2bf(float f) { unsigned u = __float_as_uint(f); return (u + 0x7fffu + ((u >> 16) & 1u)) >> 16; }
typedef float f32x2_t_ __attribute__((ext_vector_type(2))); typedef __bf16 bf16x2_t_ __attribute__((ext_vector_type(2)));
__device__ __forceinline__ unsigned pk2(float lo, float hi) { const f32x2_t_ v = {lo, hi}; const bf16x2_t_ b = __builtin_convertvector(v, bf16x2_t_); return __builtin_bit_cast(unsigned, b); }
__device__ __forceinline__ float sigmoidf_(float x) { return __builtin_amdgcn_rcpf(1.0f + __builtin_amdgcn_exp2f(-1.4426950408889634f * x)); }
__device__ __forceinline__ float gelu_tanh(float x) { const float u = 0.7978845608028654f * (x + 0.044715f * x * x * x); return x * sigmoidf_(2.0f * u); }
template <int X> __device__ __forceinline__ float swz_xor(float v) { return __int_as_float(__builtin_amdgcn_ds_swizzle(__float_as_int(v), 0x1F | (X << 10))); }
__device__ __forceinline__ float half_sum(float v) { const auto r = __builtin_amdgcn_permlane32_swap(__float_as_uint(v), __float_as_uint(v), false, false); return __uint_as_float(r[0]) + __uint_as_float(r[1]); }
__device__ __forceinline__ float half_max(float v) { const auto r = __builtin_amdgcn_permlane32_swap(__float_as_uint(v), __float_as_uint(v), false, false); return fmaxf(__uint_as_float(r[0]), __uint_as_float(r[1])); }
__device__ __forceinline__ float wave_sum(float v) { v += swz_xor<1>(v); v += swz_xor<2>(v); v += swz_xor<4>(v); v += swz_xor<8>(v); v += swz_xor<16>(v); return half_sum(v); }
__device__ __forceinline__ int t5_bucket(int dist) {
    if (dist < 16) return dist;
    int k = 16;
    k += dist >= 22; k += dist >= 30; k += dist >= 40; k += dist >= 54; k += dist >= 73; k += dist >= 99; k += dist >= 134; k += dist >= 182;
    k += dist >= 246; k += dist >= 332; k += dist >= 450; k += dist >= 609; k += dist >= 825; k += dist >= 1117; k += dist >= 1513;
    return k;
}
__device__ __forceinline__ float row_rstd16(const float* SSQ, int row) {
    typedef float f4 __attribute__((ext_vector_type(4)));
    const f4* p = (const f4*)(SSQ + (size_t)row * 16); const f4 a = p[0], b = p[1], c = p[2], d = p[3];
    const float s = ((a.x + a.y) + (a.z + a.w)) + ((b.x + b.y) + (b.z + b.w)) + ((c.x + c.y) + (c.z + c.w)) + ((d.x + d.y) + (d.z + d.w));
    return rsqrtf(s * (1.0f / C::D) + C::EPS);
}
namespace pg8 {
#define PG8_LAS __attribute__((address_space(3)))
typedef unsigned short bf16_t;
typedef short bf16x8 __attribute__((ext_vector_type(8)));
typedef float f32x4 __attribute__((ext_vector_type(4)));
typedef unsigned u32x4 __attribute__((ext_vector_type(4)));
typedef int i32x4 __attribute__((ext_vector_type(4)));
constexpr int WCS = 64, BJS = 32;
constexpr int BM = 256, BK = 64, HALF = 128, HTB = HALF * BK * 2  , STAGE_BYTES = 8 * HTB, NXCD = 8, WGM = 8;

__host__ __device__ __forceinline__ int lds_byte(int r, int c) { const int st = (r >> 4) * 2 + (c >> 5), rr = r & 15, cc = c & 31, ob = rr * 64 + cc * 2; return st * 1024 + (ob ^ (((ob >> 9) & 1) << 5)); }
__host__ __device__ __forceinline__ void stage_rc(int b, int& R, int& C) { const int st = b / 1024, sb = b % 1024, swz = sb ^ (((sb >> 9) & 1) << 5); R = (st >> 1) * 16 + swz / 64; C = (st & 1) * 32 + (swz % 64) / 2; }
__host__ __device__ __forceinline__ int perm32(int rho) { const int n = rho >> 4, i = rho & 15; return 8 * (i >> 2) + 4 * n + (i & 3); }

struct Unit { int pm, pn, ko; };
struct Gemm { const bf16_t* A; const bf16_t* Bt; int M, N, K, lda, ldb; };

struct StaticOrder {
    int nM, nN, nwg, G, c;
    __host__ __device__ void init(int M, int N, int G_, int c_) { nM = M / BM; nN = N / BM; nwg = nM * nN; G = G_; c = c_; }
    __host__ __device__ bool next(int i, Unit& u) const {
        const long L = (long)i * G + c; if (L >= nwg) return false;
        int wgid = (int)L; { const int q = nwg / NXCD, r = nwg % NXCD, xcd = wgid % NXCD, off = wgid / NXCD; wgid = (xcd < r ? xcd * (q + 1) : r * (q + 1) + (xcd - r) * q) + off; }
        const int nig = WGM * nN, gid = wgid / nig, fm = gid * WGM, gsz = (nM - fm) < WGM ? (nM - fm) : WGM;
        u.pm = fm + ((wgid % nig) % gsz); u.pn = (wgid % nig) / gsz; u.ko = 0; return true;
    }
    __device__ __forceinline__ void a_ready(const Unit&) const {}
    __device__ __forceinline__ void done(const Unit&) const {}
};
struct PartOrder {
    int pm, l0, nl, h0, cnt;
    __host__ __device__ void init(int c, int NL) { const int x = c % NXCD, off = c / NXCD, gq = off / WGM; pm = x * WGM + off % WGM;
        if (gq == 0) { l0 = 0; nl = 1; h0 = NL; cnt = 5; } else { l0 = 1 + 3 * (gq - 1); nl = 3; h0 = NL + 4 + 4 * (gq - 1); cnt = 7; } }
    __host__ __device__ int tile(int i) const { return i < nl ? l0 + i : h0 + (i - nl); }
    __host__ __device__ int slot(int pn, int NL) const { return pn < NL ? pn - l0 : nl + pn - h0; }
    __host__ __device__ bool next(int i, Unit& u) const { if (i >= cnt) return false; u.pm = pm; u.pn = tile(i); u.ko = 0; return true; }
    __device__ __forceinline__ void a_ready(const Unit&) const {}
    __device__ __forceinline__ void done(const Unit&) const {}
};

__device__ __forceinline__ unsigned cvt_pk_bf16(float lo, float hi) { unsigned r; asm volatile("v_cvt_pk_bf16_f32 %0, %1, %2" : "=v"(r) : "v"(lo), "v"(hi)); return r; }
typedef float f32x2 __attribute__((ext_vector_type(2)));
struct EpiInproj {
    static constexpr bool PERM = true, AFTER_DRAIN = false, I8 = false; static constexpr int NST = 16;
    const float* SSQ; bf16_t *za, *zb, *zqkv, *zd; unsigned char* g; const PG8_LAS float* rtab; int pm_tab; unsigned char* wsb;
    __device__ __forceinline__ void operator()(const f32x4 (&acc)[2][2][4][2], const Unit& u, int wr, int wc, int fr, int fq) const {
        const int row0 = u.pm * BM + wr * 64 + fr, pn = u.pn;
        bf16_t* base = za; int ldc = 512, colt = pn * 256, mode = 1;
        if (pn >= 15) { mode = 2; colt = (pn - 15) * 256; }
        else if (pn >= 14) { base = zd; ldc = 256; colt = 0; mode = 0; }
        else if (pn >= 5) { base = zqkv; ldc = 2304; colt = (pn - 5) * 256; mode = 0; }
        else if (pn >= 2) { base = zb; ldc = 768; colt = (pn - 2) * 256; mode = 0; }
        const int col0 = colt + wc * WCS + 8 * fq;
        const __amdgpu_buffer_rsrc_t wrs = __builtin_amdgcn_make_buffer_rsrc(wsb, 0, (int)C::WS_END, 0x00020000);
        const size_t boff = (size_t)((const unsigned char*)base - wsb), goff = (size_t)(g - wsb);
        const float qsc = (pn >= 5 && pn < 8) ? 0.18033688011112042f : 1.0f;
        float rs[8];
        if (u.pm == pm_tab) {
#pragma unroll
            for (int i = 0; i < 8; ++i) rs[i] = rtab[wr * 64 + fr + (i >> 2) * HALF + (i & 3) * 16];
        } else {
#pragma unroll
            for (int i = 0; i < 8; ++i) { const f32x4 t = *(const f32x4*)(SSQ + (size_t)(row0 + (i >> 2) * HALF + (i & 3) * 16) * 16 + fq * 4); rs[i] = (t[0] + t[1]) + (t[2] + t[3]); }
#pragma unroll
            for (int i = 0; i < 8; ++i) { float v = rs[i]; v += swz_xor<16>(v); v = half_sum(v); rs[i] = rsqrtf(v * (1.0f / C::D) + C::EPS); }
        }
#pragma unroll
        for (int ai = 0; ai < 2; ++ai)
#pragma unroll
            for (int m = 0; m < 4; ++m) {
                const int row = row0 + ai * HALF + m * 16; const float rstd = rs[ai * 4 + m] * qsc;
#pragma unroll
                for (int bj = 0; bj < 2; ++bj) {
                    f32x4 v0 = acc[ai][bj][m][0] * rstd, v1 = acc[ai][bj][m][1] * rstd;
                    if (mode == 2) {
                        unsigned lo = 0, hi = 0;
#pragma unroll
                        for (int e = 0; e < 4; ++e) { lo = __builtin_amdgcn_cvt_pk_u8_f32(__builtin_floorf(sigmoidf_(v0[e]) * 255.0f + 0.5f), e, lo); hi = __builtin_amdgcn_cvt_pk_u8_f32(__builtin_floorf(sigmoidf_(v1[e]) * 255.0f + 0.5f), e, hi); }
                        typedef unsigned u32x2 __attribute__((ext_vector_type(2)));
                        __builtin_amdgcn_raw_buffer_store_b64((u32x2){lo, hi}, wrs, (unsigned)(goff + (size_t)row * 4096 + col0 + bj * BJS), 0, 16);
                    } else {
                        if (mode == 1) {
#pragma unroll
                            for (int e = 0; e < 4; ++e) { v0[e] = gelu_tanh(v0[e]); v1[e] = gelu_tanh(v1[e]); }
                        }
                        u32x4 w; w.x = cvt_pk_bf16(v0[0], v0[1]); w.y = cvt_pk_bf16(v0[2], v0[3]); w.z = cvt_pk_bf16(v1[0], v1[1]); w.w = cvt_pk_bf16(v1[2], v1[3]);
                        __builtin_amdgcn_raw_buffer_store_b128(w, wrs, (unsigned)(boff + ((size_t)row * ldc + col0 + bj * BJS) * 2), 0, 16);
                    }
                }
            }
    }
};
struct EpiInprojI8 {
    static constexpr bool PERM = true, AFTER_DRAIN = false, I8 = true; static constexpr int NST = 16;
    bf16_t *za, *zb, *zqkv, *zd; unsigned char* g; const PG8_LAS float *ctab, *xtab; unsigned char* wsb; int pn_off, l0, nl, h0;
    __device__ __forceinline__ void operator()(const f32x4 (&acc)[2][2][4][2], const Unit& u, int wr, int wc, int fr, int fq) const {
        const int row0 = u.pm * BM + wr * 64 + fr, pn = u.pn + pn_off;
        bf16_t* base = za; int ldc = 512, colt = pn * 256, mode = 1;
        if (pn >= 15) { mode = 2; colt = (pn - 15) * 256; }
        else if (pn >= 14) { base = zd; ldc = 256; colt = 0; mode = 0; }
        else if (pn >= 5) { base = zqkv; ldc = 2304; colt = (pn - 5) * 256; mode = 0; }
        else if (pn >= 2) { base = zb; ldc = 768; colt = (pn - 2) * 256; mode = 0; }
        const int col0 = colt + wc * WCS + 8 * fq;
        const __amdgpu_buffer_rsrc_t wrs = __builtin_amdgcn_make_buffer_rsrc(wsb, 0, (int)C::WS_END, 0x00020000);
        const size_t boff = (size_t)((const unsigned char*)base - wsb), goff = (size_t)(g - wsb);
        const float qsc = (pn >= 5 && pn < 8) ? 0.18033688011112042f : 1.0f;
        float xs[8];
#pragma unroll
        for (int i = 0; i < 8; ++i) xs[i] = xtab[wr * 64 + fr + (i >> 2) * HALF + (i & 3) * 16];
#pragma unroll
        for (int bj = 0; bj < 2; ++bj) {
            const PG8_LAS float* cp = ctab + (u.pn < 10 ? u.pn - l0 : nl + u.pn - h0) * 256 + wc * WCS + 8 * fq + bj * BJS; const f32x4 cf0 = *(const PG8_LAS f32x4*)cp * qsc, cf1 = *(const PG8_LAS f32x4*)(cp + 4) * qsc;
#pragma unroll
            for (int ai = 0; ai < 2; ++ai)
#pragma unroll
                for (int m = 0; m < 4; ++m) {
                    const int row = row0 + ai * HALF + m * 16;
                    {
                    const i32x4 a0 = __builtin_bit_cast(i32x4, acc[ai][bj][m][0]), a1 = __builtin_bit_cast(i32x4, acc[ai][bj][m][1]);
                    const float xf = xs[ai * 4 + m]; f32x4 v0 = __builtin_convertvector(a0, f32x4) * (cf0 * xf), v1 = __builtin_convertvector(a1, f32x4) * (cf1 * xf);
                    if (mode == 2) {
                        unsigned lo = 0, hi = 0;
#pragma unroll
                        for (int e = 0; e < 4; ++e) { lo = __builtin_amdgcn_cvt_pk_u8_f32(__builtin_floorf(sigmoidf_(v0[e]) * 255.0f + 0.5f), e, lo); hi = __builtin_amdgcn_cvt_pk_u8_f32(__builtin_floorf(sigmoidf_(v1[e]) * 255.0f + 0.5f), e, hi); }
                        typedef unsigned u32x2 __attribute__((ext_vector_type(2)));
                        __builtin_amdgcn_raw_buffer_store_b64((u32x2){lo, hi}, wrs, (unsigned)(goff + (size_t)row * 4096 + col0 + bj * BJS), 0, 16);
                    } else {
                        if (mode == 1) {
#pragma unroll
                            for (int e = 0; e < 4; ++e) { v0[e] = gelu_tanh(v0[e]); v1[e] = gelu_tanh(v1[e]); }
                        }
                        u32x4 w; w.x = cvt_pk_bf16(v0[0], v0[1]); w.y = cvt_pk_bf16(v0[2], v0[3]); w.z = cvt_pk_bf16(v1[0], v1[1]); w.w = cvt_pk_bf16(v1[2], v1[3]);
                        __builtin_amdgcn_raw_buffer_store_b128(w, wrs, (unsigned)(boff + ((size_t)row * ldc + col0 + bj * BJS) * 2), 0, 16);
                    }
                    }
                }
        }
    }
};
struct EpiFF1 {
    static constexpr bool PERM = true, AFTER_DRAIN = false, I8 = false; static constexpr int NST = 16;
    const float* SSQ; bf16_t* H; const PG8_LAS float* rtab; int pm_tab;
    __device__ __forceinline__ void operator()(const f32x4 (&acc)[2][2][4][2], const Unit& u, int wr, int wc, int fr, int fq) const {
        const int row0 = u.pm * BM + wr * 64 + fr, col0 = u.pn * BM + wc * WCS + 8 * fq;
        const __amdgpu_buffer_rsrc_t hrs = __builtin_amdgcn_make_buffer_rsrc(H, 0, (int)((size_t)C::T * C::DFF * 2), 0x00020000);
        float rs[8];
        if (u.pm == pm_tab) {
#pragma unroll
            for (int i = 0; i < 8; ++i) rs[i] = rtab[wr * 64 + fr + (i >> 2) * HALF + (i & 3) * 16];
        } else {
#pragma unroll
            for (int i = 0; i < 8; ++i) { const f32x4 t = *(const f32x4*)(SSQ + (size_t)(row0 + (i >> 2) * HALF + (i & 3) * 16) * 16 + fq * 4); rs[i] = (t[0] + t[1]) + (t[2] + t[3]); }
#pragma unroll
            for (int i = 0; i < 8; ++i) { float v = rs[i]; v += swz_xor<16>(v); v = half_sum(v); rs[i] = rsqrtf(v * (1.0f / C::D) + C::EPS); }
        }
#pragma unroll
        for (int ai = 0; ai < 2; ++ai)
#pragma unroll
            for (int m = 0; m < 4; ++m) {
                const int row = row0 + ai * HALF + m * 16; const float rstd = rs[ai * 4 + m];
#pragma unroll
                for (int bj = 0; bj < 2; ++bj) {
                    f32x4 v0 = acc[ai][bj][m][0] * rstd, v1 = acc[ai][bj][m][1] * rstd;
#pragma unroll
                    for (int e = 0; e < 4; ++e) { const float a = fmaxf(v0[e], 0.f), b = fmaxf(v1[e], 0.f); v0[e] = a * a; v1[e] = b * b; }
                    u32x4 w; w.x = cvt_pk_bf16(v0[0], v0[1]); w.y = cvt_pk_bf16(v0[2], v0[3]); w.z = cvt_pk_bf16(v1[0], v1[1]); w.w = cvt_pk_bf16(v1[2], v1[3]);
                    __builtin_amdgcn_raw_buffer_store_b128(w, hrs, (unsigned)(((size_t)row * C::DFF + col0 + bj * BJS) * 2), 0, 16);
                }
            }
    }
};
struct EpiFF1I8 {
    static constexpr bool PERM = true, AFTER_DRAIN = false, I8 = true; static constexpr int NST = 16;
    bf16_t* H; const PG8_LAS float *ctab, *xtab;
    __device__ __forceinline__ void operator()(const f32x4 (&acc)[2][2][4][2], const Unit& u, int wr, int wc, int fr, int fq) const {
        const int row0 = u.pm * BM + wr * 64 + fr, col0 = u.pn * BM + wc * WCS + 8 * fq;
        const __amdgpu_buffer_rsrc_t hrs = __builtin_amdgcn_make_buffer_rsrc(H, 0, (int)((size_t)C::T * C::DFF * 2), 0x00020000);
        float xs[8];
#pragma unroll
        for (int i = 0; i < 8; ++i) xs[i] = xtab[wr * 64 + fr + (i >> 2) * HALF + (i & 3) * 16];
#pragma unroll
        for (int bj = 0; bj < 2; ++bj) {
            const PG8_LAS float* cp = ctab + (u.pn >> 2) * 256 + wc * WCS + 8 * fq + bj * BJS; const f32x4 cf0 = *(const PG8_LAS f32x4*)cp, cf1 = *(const PG8_LAS f32x4*)(cp + 4);
#pragma unroll
            for (int ai = 0; ai < 2; ++ai)
#pragma unroll
                for (int m = 0; m < 4; ++m) {
                    const int row = row0 + ai * HALF + m * 16;
                    const i32x4 a0 = __builtin_bit_cast(i32x4, acc[ai][bj][m][0]), a1 = __builtin_bit_cast(i32x4, acc[ai][bj][m][1]);
                    const float xf = xs[ai * 4 + m]; f32x4 v0 = __builtin_convertvector(a0, f32x4) * (cf0 * xf), v1 = __builtin_convertvector(a1, f32x4) * (cf1 * xf);
#pragma unroll
                    for (int e = 0; e < 4; ++e) { const float a = fmaxf(v0[e], 0.f), b = fmaxf(v1[e], 0.f); v0[e] = a * a; v1[e] = b * b; }
                    u32x4 w; w.x = cvt_pk_bf16(v0[0], v0[1]); w.y = cvt_pk_bf16(v0[2], v0[3]); w.z = cvt_pk_bf16(v1[0], v1[1]); w.w = cvt_pk_bf16(v1[2], v1[3]);
                    __builtin_amdgcn_raw_buffer_store_b128(w, hrs, (unsigned)(((size_t)row * C::DFF + col0 + bj * BJS) * 2), 0, 16);
                }
        }
    }
};
struct EpiResid {
    static constexpr bool PERM = true, AFTER_DRAIN = false, I8 = false; static constexpr int NST = 0;
    bf16_t* XB; float* SSQ;
    __device__ __forceinline__ void operator()(const f32x4 (&acc)[2][2][4][2], const Unit& u, int wr, int wc, int fr, int fq) const {
        const int row0 = u.pm * BM + wr * 64 + fr, col0 = u.pn * BM + wc * WCS + 8 * fq;
        u32x4 xv[2][4][2];
#pragma unroll
        for (int ai = 0; ai < 2; ++ai)
#pragma unroll
            for (int m = 0; m < 4; ++m)
#pragma unroll
                for (int bj = 0; bj < 2; ++bj) xv[ai][m][bj] = *(const u32x4*)(XB + (size_t)(row0 + ai * HALF + m * 16) * C::D + col0 + bj * BJS);
        asm volatile("" ::: "memory");
#pragma unroll
        for (int ai = 0; ai < 2; ++ai)
#pragma unroll
            for (int m = 0; m < 4; ++m) {
                const int row = row0 + ai * HALF + m * 16; float ss = 0.f;
#pragma unroll
                for (int bj = 0; bj < 2; ++bj) {
                    const u32x4 xr = xv[ai][m][bj]; u32x4 w;
#pragma unroll
                    for (int q = 0; q < 4; ++q) {
                        const f32x4& a = acc[ai][bj][m][q >> 1];
                        const float y0 = __uint_as_float(xr[q] << 16) + a[2 * (q & 1)], y1 = __uint_as_float(xr[q] & 0xffff0000u) + a[2 * (q & 1) + 1];
                        w[q] = cvt_pk_bf16(y0, y1);
                        const float r0 = __uint_as_float(w[q] << 16), r1 = __uint_as_float(w[q] & 0xffff0000u);
                        ss += r0 * r0 + r1 * r1;
                    }
                    *(u32x4*)(XB + (size_t)row * C::D + col0 + bj * BJS) = w;
                }
                ss += swz_xor<16>(ss); ss = half_sum(ss);
                if (fq == 0) SSQ[(size_t)row * 16 + u.pn * 4 + wc] = ss;
            }
    }
};
template <bool I8> __device__ __forceinline__ f32x4 mma16(bf16x8 b, bf16x8 a, f32x4 c) {
    if constexpr (I8) return __builtin_bit_cast(f32x4, __builtin_amdgcn_mfma_i32_16x16x64_i8(__builtin_bit_cast(i32x4, b), __builtin_bit_cast(i32x4, a), __builtin_bit_cast(i32x4, c), 0, 0, 0));
    else return __builtin_amdgcn_mfma_f32_16x16x32_bf16(b, a, c, 0, 0, 0);
}
template <class Epi, class Sched, bool ALIGN_EPI = false, bool SP2 = false>
__device__ __forceinline__ void gemm_phase(PG8_LAS unsigned char* lds, const Gemm g, const Sched& S, const Epi& E, const int wid_in) {
    int lane; asm volatile("v_mbcnt_lo_u32_b32 %0, -1, 0\n\tv_mbcnt_hi_u32_b32 %0, -1, %0" : "=v"(lane));
    const int wid = wid_in, tid = wid * 64 + lane, wr = wid >> 2, wc = wid & 3, fr = lane & 15, fq = lane >> 4;
    const int K = g.K, nt = K / BK;
    unsigned voffA[2], voffB[2];
#pragma unroll
    for (int i = 0; i < 2; ++i) { int R, C; stage_rc(tid * 16 + i * 8192, R, C); const int Rb = Epi::PERM ? (WCS * (R >> 5) + perm32(R & 31)) : R;
        voffA[i] = (unsigned)(R * g.lda + C) * 2u; voffB[i] = (unsigned)(Rb * g.ldb + C) * 2u; }
    const size_t kstep = (size_t)(BK * 2);
    const size_t hstepA = (size_t)HALF * g.lda * 2, hstepB = (size_t)BJS * g.ldb * 2;
    const size_t tstepA = 2 * hstepA, tstepB = (size_t)BM * g.ldb * 2;
    const unsigned ldsw = (unsigned)wid * 1024u;
    const int aoff = lds_byte(wr * 64 + fr, fq * 8), boff = lds_byte(wc * 32 + fr, fq * 8);
#define PG8_SA(b, h) (((b) * 2 + (h)) * HTB)
#define PG8_SB(b, h) ((4 + (b) * 2 + (h)) * HTB)
#define PG8_STAGE(bufoff, gbase, voff) do { _Pragma("unroll") for (int _i = 0; _i < 2; ++_i) \
        __builtin_amdgcn_global_load_lds((const unsigned*)((const char*)(gbase) + (voff)[_i]), (PG8_LAS unsigned*)(lds + (bufoff) + ldsw + _i * 8192), 16, 0, 0); } while (0)
#define PG8_LDA(dst, b, h) do { _Pragma("unroll") for (int m = 0; m < 4; ++m) _Pragma("unroll") for (int k = 0; k < 2; ++k) dst[m][k] = *(const PG8_LAS bf16x8*)(lds + PG8_SA(b, h) + aoff + m * 2048 + k * 1024); } while (0)
#define PG8_LDB(dst, b, h) do { _Pragma("unroll") for (int n = 0; n < 2; ++n) _Pragma("unroll") for (int k = 0; k < 2; ++k) dst[n][k] = *(const PG8_LAS bf16x8*)(lds + PG8_SB(b, h) + boff + n * 2048 + k * 1024); } while (0)
#define PG8_MMA(ai, bj, At, Bt) do { __builtin_amdgcn_s_setprio(1); _Pragma("unroll") for (int m = 0; m < 4; ++m) _Pragma("unroll") for (int n = 0; n < 2; ++n) _Pragma("unroll") for (int k = 0; k < 2; ++k) \
        acc[ai][bj][m][n] = mma16<Epi::I8>(Bt[n][k], At[m][k], acc[ai][bj][m][n]); __builtin_amdgcn_s_setprio(0); } while (0)
#define PG8_WAIT_V(n) asm volatile("s_waitcnt vmcnt(" #n ")" ::: "memory")
#define PG8_WAIT_L(n) asm volatile("s_waitcnt lgkmcnt(" #n ")" ::: "memory")
#define PG8_BAR __builtin_amdgcn_s_barrier()
#define PG8_SCHED __builtin_amdgcn_sched_barrier(0)
    Unit cur, nxt; int ui = 0;
    if (!S.next(0, cur)) return;
    f32x4 acc[2][2][4][2];
#pragma unroll
    for (int a = 0; a < 2; ++a)
#pragma unroll
        for (int b = 0; b < 2; ++b)
#pragma unroll
            for (int m = 0; m < 4; ++m)
#pragma unroll
                for (int n = 0; n < 2; ++n) acc[a][b][m][n] = (f32x4){0.f, 0.f, 0.f, 0.f};
    bf16x8 At[4][2], B0[2][2], B1[2][2];
    const char* cA = (const char*)g.A + (size_t)cur.pm * tstepA + (size_t)cur.ko * 2; const char* cB = (const char*)g.Bt + (size_t)cur.pn * tstepB + (size_t)cur.ko * 2;
    S.a_ready(cur);
    if constexpr (SP2) {
        PG8_STAGE(PG8_SB(0, 0), cB, voffB); PG8_STAGE(PG8_SB(0, 1), cB + hstepB, voffB); PG8_STAGE(PG8_SA(0, 0), cA, voffA); PG8_STAGE(PG8_SA(0, 1), cA + hstepA, voffA);
        if (wr == 1) PG8_BAR;
        PG8_WAIT_V(2); PG8_BAR;
        PG8_STAGE(PG8_SB(1, 0), cB + kstep, voffB); PG8_STAGE(PG8_SA(1, 0), cA + kstep, voffA); PG8_STAGE(PG8_SB(1, 1), cB + hstepB + kstep, voffB);
        PG8_WAIT_V(6); PG8_BAR;
    } else {
        PG8_STAGE(PG8_SB(0, 0), cB, voffB); PG8_STAGE(PG8_SA(0, 0), cA, voffA); PG8_STAGE(PG8_SB(0, 1), cB + hstepB, voffB); PG8_STAGE(PG8_SA(0, 1), cA + hstepA, voffA);
        if (wr == 1) PG8_BAR;
        PG8_WAIT_V(4); PG8_BAR;
        PG8_STAGE(PG8_SB(1, 0), cB + kstep, voffB); PG8_STAGE(PG8_SA(1, 0), cA + kstep, voffA); PG8_STAGE(PG8_SB(1, 1), cB + hstepB + kstep, voffB);
        PG8_WAIT_V(6); PG8_BAR;
    }
    for (;;) {
        const bool has_next = S.next(ui + 1, nxt);
        const char* nA = has_next ? (const char*)g.A + (size_t)nxt.pm * tstepA + (size_t)nxt.ko * 2 : cA; const char* nB = has_next ? (const char*)g.Bt + (size_t)nxt.pn * tstepB + (size_t)nxt.ko * 2 : cB;
        for (int t = 0; t < nt; t += 2) {
            const bool last = (t == nt - 2);
            const char* a1 = cA + (size_t)(t + 1) * kstep;
            const char* a2 = last ? nA : cA + (size_t)(t + 2) * kstep; const char* b2 = last ? nB : cB + (size_t)(t + 2) * kstep;
            const char* a3 = a2 + kstep; const char* b3 = b2 + kstep;
            if (last && has_next) S.a_ready(nxt);
            if constexpr (SP2) {
            PG8_LDB(B0, 0, 0); PG8_LDB(B1, 0, 1); PG8_SCHED; PG8_LDA(At, 0, 0); PG8_STAGE(PG8_SA(1, 1), a1 + hstepA, voffA);
            PG8_WAIT_V(8); PG8_WAIT_L(0); PG8_BAR; PG8_MMA(0, 0, At, B0); PG8_MMA(0, 1, At, B1); PG8_BAR; PG8_SCHED;
            PG8_LDA(At, 0, 1); PG8_STAGE(PG8_SB(0, 0), b2, voffB); PG8_STAGE(PG8_SB(0, 1), b2 + hstepB, voffB); PG8_STAGE(PG8_SA(0, 0), a2, voffA);
            PG8_WAIT_V(8); PG8_WAIT_L(0); PG8_BAR; PG8_MMA(1, 0, At, B0); PG8_MMA(1, 1, At, B1); PG8_BAR; PG8_SCHED;
            PG8_LDB(B0, 1, 0); PG8_LDB(B1, 1, 1); PG8_SCHED; PG8_LDA(At, 1, 0); PG8_STAGE(PG8_SA(0, 1), a2 + hstepA, voffA);
            PG8_WAIT_V(8); PG8_WAIT_L(0); PG8_BAR; PG8_MMA(0, 0, At, B0); PG8_MMA(0, 1, At, B1); PG8_BAR; PG8_SCHED;
            PG8_LDA(At, 1, 1); PG8_STAGE(PG8_SB(1, 0), b3, voffB); PG8_STAGE(PG8_SB(1, 1), b3 + hstepB, voffB); PG8_STAGE(PG8_SA(1, 0), a3, voffA);
            PG8_WAIT_V(8); PG8_WAIT_L(0); PG8_BAR; PG8_MMA(1, 0, At, B0); PG8_MMA(1, 1, At, B1); PG8_BAR; PG8_SCHED;
            } else {
            PG8_LDB(B0, 0, 0); PG8_SCHED; PG8_LDA(At, 0, 0); PG8_STAGE(PG8_SA(1, 1), a1 + hstepA, voffA);
            PG8_WAIT_L(8); PG8_BAR; PG8_WAIT_L(0); PG8_MMA(0, 0, At, B0); PG8_BAR; PG8_SCHED;
            PG8_LDB(B1, 0, 1); PG8_STAGE(PG8_SB(0, 0), b2, voffB);
            PG8_BAR; PG8_WAIT_L(0); PG8_MMA(0, 1, At, B1); PG8_BAR;
            PG8_LDA(At, 0, 1); PG8_STAGE(PG8_SA(0, 0), a2, voffA);
            PG8_BAR; PG8_WAIT_L(0); PG8_MMA(1, 0, At, B0); PG8_BAR; PG8_SCHED;
            PG8_STAGE(PG8_SB(0, 1), b2 + hstepB, voffB);
            PG8_WAIT_V(6); PG8_BAR; PG8_MMA(1, 1, At, B1); PG8_BAR;
            PG8_LDB(B0, 1, 0); PG8_SCHED; PG8_LDA(At, 1, 0); PG8_STAGE(PG8_SA(0, 1), a2 + hstepA, voffA);
            PG8_WAIT_L(8); PG8_BAR; PG8_WAIT_L(0); PG8_MMA(0, 0, At, B0); PG8_BAR; PG8_SCHED;
            PG8_LDB(B1, 1, 1); PG8_STAGE(PG8_SB(1, 0), b3, voffB);
            PG8_BAR; PG8_WAIT_L(0); PG8_MMA(0, 1, At, B1); PG8_BAR;
            PG8_LDA(At, 1, 1); PG8_STAGE(PG8_SA(1, 0), a3, voffA);
            PG8_BAR; PG8_WAIT_L(0); PG8_MMA(1, 0, At, B0); PG8_BAR; PG8_SCHED;
            PG8_STAGE(PG8_SB(1, 1), b3 + hstepB, voffB);
            PG8_WAIT_V(6); PG8_BAR; PG8_MMA(1, 1, At, B1); PG8_BAR;
            }
        }
        if constexpr (ALIGN_EPI) { if (wr == 0) PG8_BAR; }
        if constexpr (!Epi::AFTER_DRAIN) { E(acc, cur, wr, wc, fr, fq); S.done(cur); }
        if (!has_next) break;
#pragma unroll
        for (int a = 0; a < 2; ++a)
#pragma unroll
            for (int b = 0; b < 2; ++b)
#pragma unroll
                for (int m = 0; m < 4; ++m)
#pragma unroll
                    for (int n = 0; n < 2; ++n) acc[a][b][m][n] = (f32x4){0.f, 0.f, 0.f, 0.f};
        cur = nxt; cA = nA; cB = nB; ++ui;
        if constexpr (ALIGN_EPI) { if (wr == 1) PG8_BAR; }
    }
    PG8_WAIT_V(0);
    if constexpr (!ALIGN_EPI) { if (wr == 0) PG8_BAR; }
    PG8_BAR;
    if constexpr (Epi::AFTER_DRAIN) { E.fused(acc, cur, wr, wc, fr, fq, lds, wid, lane); S.done(cur); }
#undef PG8_SA
#undef PG8_SB
#undef PG8_STAGE
#undef PG8_LDA
#undef PG8_LDB
#undef PG8_MMA
#undef PG8_WAIT_V
#undef PG8_WAIT_L
#undef PG8_BAR
#undef PG8_SCHED
}
}
namespace pg8 {
__device__ __forceinline__ void gemm_merge_phase(PG8_LAS unsigned char* lds, const bf16_t* A, const bf16_t* Bt, const unsigned char* G, bf16_t* O, const int vcu, const int nwgs, const int wid_in) {
    int lane; asm volatile("v_mbcnt_lo_u32_b32 %0, -1, 0\n\tv_mbcnt_hi_u32_b32 %0, -1, %0" : "=v"(lane));
    const int wid = wid_in, tid = wid * 64 + lane, wr = wid >> 2, wc = wid & 3, fr = lane & 15, fq = lane >> 4;
    constexpr int K = C::D, nt = K / BK, LD = C::D;
    constexpr int NUNITS = (C::T / 256) * (C::D / 128);
    unsigned voffA[2], voffB[2];
#pragma unroll
    for (int i = 0; i < 2; ++i) { int R, Cc; stage_rc(tid * 16 + i * 8192, R, Cc); const int Rb = (R & ~31) + perm32(R & 31);
        voffA[i] = (unsigned)(R * LD + Cc) * 2u; voffB[i] = (unsigned)(Rb * LD + Cc) * 2u; }
    constexpr size_t kstep = (size_t)(BK * 2), hstep = (size_t)HALF * LD * 2;
    const unsigned ldsw = (unsigned)wid * 1024u;
    const int aoff = lds_byte(wr * 64 + fr, fq * 8), boff = lds_byte(wc * 32 + fr, fq * 8);
#define PG8_SA(b, h) (((b) * 2 + (h)) * HTB)
#define PG8_SB(b, h) ((4 + (b) * 2 + (h)) * HTB)
#define PG8_STAGE(bufoff, gbase, voff) do { _Pragma("unroll") for (int _i = 0; _i < 2; ++_i) \
        __builtin_amdgcn_global_load_lds((const unsigned*)((const char*)(gbase) + (voff)[_i]), (PG8_LAS unsigned*)(lds + (bufoff) + ldsw + _i * 8192), 16, 0, 0); } while (0)
#define PG8_LDA(dst, b, h) do { _Pragma("unroll") for (int m = 0; m < 4; ++m) _Pragma("unroll") for (int k = 0; k < 2; ++k) dst[m][k] = *(const PG8_LAS bf16x8*)(lds + PG8_SA(b, h) + aoff + m * 2048 + k * 1024); } while (0)
#define PG8_LDB(dst, b, h) do { _Pragma("unroll") for (int n = 0; n < 2; ++n) _Pragma("unroll") for (int k = 0; k < 2; ++k) dst[n][k] = *(const PG8_LAS bf16x8*)(lds + PG8_SB(b, h) + boff + n * 2048 + k * 1024); } while (0)
#define PG8_MMA(ai, At, Bt) do { __builtin_amdgcn_s_setprio(1); _Pragma("unroll") for (int m = 0; m < 4; ++m) _Pragma("unroll") for (int n = 0; n < 2; ++n) _Pragma("unroll") for (int k = 0; k < 2; ++k) \
        acc[ai][m][n] = __builtin_amdgcn_mfma_f32_16x16x32_bf16(Bt[n][k], At[m][k], acc[ai][m][n], 0, 0, 0); __builtin_amdgcn_s_setprio(0); } while (0)
#define PG8_WAIT_V(n) asm volatile("s_waitcnt vmcnt(" #n ")" ::: "memory")
#define PG8_WAIT_L(n) asm volatile("s_waitcnt lgkmcnt(" #n ")" ::: "memory")
#define PG8_BAR __builtin_amdgcn_s_barrier()
#define PG8_SCHED __builtin_amdgcn_sched_barrier(0)
    int L = vcu;
    if (L >= NUNITS) return;
    f32x4 acc[2][4][2], tot[2][4][2];
#pragma unroll
    for (int a = 0; a < 2; ++a)
#pragma unroll
        for (int m = 0; m < 4; ++m)
#pragma unroll
            for (int n = 0; n < 2; ++n) { acc[a][m][n] = (f32x4){0.f, 0.f, 0.f, 0.f}; tot[a][m][n] = (f32x4){0.f, 0.f, 0.f, 0.f}; }
    bf16x8 At[4][2], B0[2][2];
    const char* cA = (const char*)A + (size_t)(L >> 3) * (2 * hstep); const char* cB = (const char*)Bt + (size_t)(L & 7) * hstep;
    PG8_STAGE(PG8_SB(0, 0), cB, voffB); PG8_STAGE(PG8_SA(0, 0), cA, voffA); PG8_STAGE(PG8_SA(0, 1), cA + hstep, voffA);
    if (wr == 1) PG8_BAR;
    PG8_WAIT_V(2); PG8_BAR;
    PG8_STAGE(PG8_SB(1, 0), cB + kstep, voffB); PG8_STAGE(PG8_SA(1, 0), cA + kstep, voffA);
    PG8_WAIT_V(4); PG8_BAR;
    for (;;) {
        const int Ln = L + nwgs; const bool has_next = Ln < NUNITS;
        const char* nA = has_next ? (const char*)A + (size_t)(Ln >> 3) * (2 * hstep) : cA; const char* nB = has_next ? (const char*)Bt + (size_t)(Ln & 7) * hstep : cB;
        const int row0 = (L >> 3) * BM + wr * 64 + fr, col0 = (L & 7) * HALF + wc * 32 + 8 * fq;
#pragma unroll 1
        for (int seg = 0; seg < 4; ++seg) {
            typedef unsigned u32x2 __attribute__((ext_vector_type(2)));
            u32x2 gv[2][4];
            int r0g = row0; asm volatile("" : "+v"(r0g));
#pragma unroll
            for (int ai = 0; ai < 2; ++ai)
#pragma unroll
                for (int m = 0; m < 4; ++m) gv[ai][m] = *(const u32x2*)(G + (size_t)(r0g + ai * HALF + m * 16) * 4096 + seg * 1024 + col0);
#pragma unroll
            for (int h2 = 0; h2 < 2; ++h2) {
                const int t = seg * 4 + h2 * 2;
                const bool last = (t == nt - 2);
                const char* a1 = cA + (size_t)(t + 1) * kstep;
                const char* a2 = last ? nA : cA + (size_t)(t + 2) * kstep; const char* b2 = last ? nB : cB + (size_t)(t + 2) * kstep;
                const char* a3 = a2 + kstep; const char* b3 = b2 + kstep;
                PG8_LDB(B0, 0, 0); PG8_SCHED; PG8_LDA(At, 0, 0); PG8_STAGE(PG8_SA(1, 1), a1 + hstep, voffA);
                PG8_WAIT_V(6); PG8_WAIT_L(0); PG8_BAR; PG8_MMA(0, At, B0); PG8_BAR; PG8_SCHED;
                PG8_LDA(At, 0, 1); PG8_STAGE(PG8_SB(0, 0), b2, voffB); PG8_STAGE(PG8_SA(0, 0), a2, voffA);
                PG8_WAIT_V(6); PG8_WAIT_L(0); PG8_BAR; PG8_MMA(1, At, B0); PG8_BAR; PG8_SCHED;
                PG8_LDB(B0, 1, 0); PG8_SCHED; PG8_LDA(At, 1, 0); PG8_STAGE(PG8_SA(0, 1), a2 + hstep, voffA);
                PG8_WAIT_V(6); PG8_WAIT_L(0); PG8_BAR; PG8_MMA(0, At, B0); PG8_BAR; PG8_SCHED;
                PG8_LDA(At, 1, 1); PG8_STAGE(PG8_SB(1, 0), b3, voffB); PG8_STAGE(PG8_SA(1, 0), a3, voffA);
                PG8_WAIT_V(6); PG8_WAIT_L(0); PG8_BAR; PG8_MMA(1, At, B0); PG8_BAR; PG8_SCHED;
            }
#pragma unroll
            for (int ai = 0; ai < 2; ++ai)
#pragma unroll
                for (int m = 0; m < 4; ++m) {
                    const u32x2 gb = gv[ai][m];
#pragma unroll
                    for (int q = 0; q < 4; ++q) {
                        tot[ai][m][0][q] += (float)((gb.x >> (8 * q)) & 255u) * (1.0f / 255.0f) * acc[ai][m][0][q];
                        tot[ai][m][1][q] += (float)((gb.y >> (8 * q)) & 255u) * (1.0f / 255.0f) * acc[ai][m][1][q];
                    }
                    acc[ai][m][0] = (f32x4){0.f, 0.f, 0.f, 0.f}; acc[ai][m][1] = (f32x4){0.f, 0.f, 0.f, 0.f};
                }
        }
        int r0e = row0; asm volatile("" : "+v"(r0e));
#pragma unroll
        for (int ai = 0; ai < 2; ++ai)
#pragma unroll
            for (int m = 0; m < 4; ++m) {
                const f32x4 v0 = tot[ai][m][0], v1 = tot[ai][m][1];
                u32x4 w; w.x = cvt_pk_bf16(v0[0], v0[1]); w.y = cvt_pk_bf16(v0[2], v0[3]); w.z = cvt_pk_bf16(v1[0], v1[1]); w.w = cvt_pk_bf16(v1[2], v1[3]);
                *(u32x4*)(O + (size_t)(r0e + ai * HALF + m * 16) * C::D + col0) = w;
                tot[ai][m][0] = (f32x4){0.f, 0.f, 0.f, 0.f}; tot[ai][m][1] = (f32x4){0.f, 0.f, 0.f, 0.f};
            }
        if (!has_next) break;
        L = Ln; cA = nA; cB = nB;
    }
    PG8_WAIT_V(0);
    if (wr == 0) PG8_BAR;
    PG8_BAR;
#undef PG8_SA
#undef PG8_SB
#undef PG8_STAGE
#undef PG8_LDA
#undef PG8_LDB
#undef PG8_MMA
#undef PG8_WAIT_V
#undef PG8_WAIT_L
#undef PG8_BAR
#undef PG8_SCHED
}
}
#define XB_TMO      128
#define XB_XCNT(j)  (256  + 64 * (j))
#define XB_XSUB(j)  (1280 + 64 * (j))
#define XB_XGEN(j)  (2304 + 64 * (j))
#define XB_TOP      3328
#define XB_TOPGEN   3392
#define XCD_BAR_WORDS 3456
#define XB_SPIN_CAP (1u << 18)

__device__ __forceinline__ unsigned xb_ld(unsigned* p)              { return __hip_atomic_load(p, __ATOMIC_RELAXED, __HIP_MEMORY_SCOPE_AGENT); }
__device__ __forceinline__ unsigned xb_add(unsigned* p, unsigned v) { return __hip_atomic_fetch_add(p, v, __ATOMIC_RELAXED, __HIP_MEMORY_SCOPE_AGENT); }
__device__ __forceinline__ unsigned xb_xcc_id() { return (unsigned)__builtin_amdgcn_s_getreg((3 << 11) | 20) & 0xFu; }
#define XB_SPIN(cond, bar) do { unsigned _sp = 0; while (cond) { __builtin_amdgcn_s_sleep(1); \
    if ((++_sp & 255u) == 0u) { if (xb_ld(&(bar)[XB_TMO])) break; if (_sp > XB_SPIN_CAP) { atomicAdd(&(bar)[XB_TMO], 1u); break; } } } } while (0)

struct XcdBarrier {
    unsigned* bar; unsigned x;
    volatile LAS unsigned* st;
};

__device__ __forceinline__ XcdBarrier xcd_barrier_post(unsigned* bar, volatile LAS unsigned* st) {
    XcdBarrier b; b.bar = bar; b.x = xb_xcc_id(); b.st = st;
    if (threadIdx.x == 0) (void)xb_add(&bar[XB_XCNT(b.x)], 1u);
    return b;
}
__device__ __forceinline__ void xcd_barrier_complete(unsigned* bar, unsigned x, unsigned& nloc, unsigned& nx) {
    const unsigned G = gridDim.x * gridDim.y * gridDim.z;
    unsigned sum, cnt, mine, sp = 0u;
    for (;;) {
        sum = 0u; cnt = 0u; mine = 0u;
#pragma unroll
        for (unsigned j = 0; j < 16; ++j) { const unsigned c = xb_ld(&bar[XB_XCNT(j)]); sum += c; cnt += (c > 0u) ? 1u : 0u; mine = (j == x) ? c : mine; }
        if (sum == G) break;
        __builtin_amdgcn_s_sleep(1);
        if ((++sp & 255u) == 0u) { if (xb_ld(&bar[XB_TMO])) break; if (sp > XB_SPIN_CAP) { atomicAdd(&bar[XB_TMO], 1u); break; } }
    }
    nloc = mine > 0u ? mine : 1u; nx = cnt > 0u ? cnt : 1u;
}

__device__ __forceinline__ void xcd_barrier(const XcdBarrier& b) {
    asm volatile("s_waitcnt vmcnt(0)" ::: "memory");
    __syncthreads();
    if (threadIdx.x == 0) {
        unsigned* bar = b.bar;
        __builtin_amdgcn_s_waitcnt(0);
        unsigned nloc = b.st[0], nx = b.st[1];
        if (nloc == 0u) { xcd_barrier_complete(bar, b.x, nloc, nx); b.st[0] = nloc; b.st[1] = nx; }
        const unsigned old = xb_add(&bar[XB_XSUB(b.x)], 1u);
        const unsigned gen = old / nloc;
        if (old + 1u == (gen + 1u) * nloc) {
            __builtin_amdgcn_fence(__ATOMIC_RELEASE, "agent");
            asm volatile("s_waitcnt vmcnt(0)" ::: "memory");
            const unsigned og = xb_add(&bar[XB_TOP], 1u);
            const unsigned tg = og / nx;
            if (og + 1u == (tg + 1u) * nx) xb_add(&bar[XB_TOPGEN], 1u);
            else XB_SPIN(xb_ld(&bar[XB_TOPGEN]) == tg, bar);
            __builtin_amdgcn_fence(__ATOMIC_ACQUIRE, "agent");
            xb_add(&bar[XB_XGEN(b.x)], 1u);
            asm volatile("s_waitcnt vmcnt(0)" ::: "memory");
        } else {
            XB_SPIN(xb_ld(&bar[XB_XGEN(b.x)]) == gen, bar);
            __builtin_amdgcn_fence(__ATOMIC_ACQUIRE, "agent");
            asm volatile("s_waitcnt vmcnt(0)" ::: "memory");
        }
    }
    __syncthreads();
}
typedef unsigned short bf16_t;
typedef short bf16x8 __attribute__((ext_vector_type(8)));
typedef float f32x4 __attribute__((ext_vector_type(4)));
typedef unsigned u32x4 __attribute__((ext_vector_type(4)));
typedef unsigned u32x2 __attribute__((ext_vector_type(2)));

__device__ __forceinline__ unsigned q8pack(float a, float b, float c, float d, float s) {
    const int qa = (int)__builtin_rintf(fminf(fmaxf(a * s, -127.f), 127.f)), qb = (int)__builtin_rintf(fminf(fmaxf(b * s, -127.f), 127.f)), qc = (int)__builtin_rintf(fminf(fmaxf(c * s, -127.f), 127.f)), qd = (int)__builtin_rintf(fminf(fmaxf(d * s, -127.f), 127.f));
    return (unsigned)(qa & 255) | ((unsigned)(qb & 255) << 8) | ((unsigned)(qc & 255) << 16) | ((unsigned)(qd & 255) << 24);
}
__device__ __forceinline__ void ph_prologue(const float* __restrict__ x, bf16_t* __restrict__ XB, float* __restrict__ SSQ, int gw, int ngw, int lane) {
    for (int row = gw; row < C::T; row += ngw) {
        const f32x4* xr = (const f32x4*)(x + (size_t)row * C::D) + lane;
        u32x2* br = (u32x2*)(XB + (size_t)row * C::D) + lane;
        f32x4 v[4]; float s = 0.f;
#pragma unroll
        for (int j = 0; j < 4; ++j) v[j] = __builtin_nontemporal_load(xr + 64 * j);
#pragma unroll
        for (int j = 0; j < 4; ++j) { u32x2 w; w.x = pk2(v[j].x, v[j].y); w.y = pk2(v[j].z, v[j].w); br[64 * j] = w;
            const float a = __uint_as_float(w.x << 16), b = __uint_as_float(w.x & 0xffff0000u), c = __uint_as_float(w.y << 16), d = __uint_as_float(w.y & 0xffff0000u); s += (a * a + b * b) + (c * c + d * d); }
        s = wave_sum(s);
        if (lane < 4) { f32x4 o = {lane == 0 ? s : 0.f, 0.f, 0.f, 0.f}; *(f32x4*)(SSQ + (size_t)row * 16 + lane * 4) = o; }
    }
}
__device__ __forceinline__ float quant_row(const u32x4 a, const u32x4 b, u32x4& o) {
    float f[16];
    f[0] = __uint_as_float(a.x << 16); f[1] = __uint_as_float(a.x & 0xffff0000u); f[2] = __uint_as_float(a.y << 16); f[3] = __uint_as_float(a.y & 0xffff0000u);
    f[4] = __uint_as_float(a.z << 16); f[5] = __uint_as_float(a.z & 0xffff0000u); f[6] = __uint_as_float(a.w << 16); f[7] = __uint_as_float(a.w & 0xffff0000u);
    f[8] = __uint_as_float(b.x << 16); f[9] = __uint_as_float(b.x & 0xffff0000u); f[10] = __uint_as_float(b.y << 16); f[11] = __uint_as_float(b.y & 0xffff0000u);
    f[12] = __uint_as_float(b.z << 16); f[13] = __uint_as_float(b.z & 0xffff0000u); f[14] = __uint_as_float(b.w << 16); f[15] = __uint_as_float(b.w & 0xffff0000u);
    float amx = 0.f;
#pragma unroll
    for (int i = 0; i < 16; ++i) amx = fmaxf(amx, fabsf(f[i]));
    amx = fmaxf(amx, swz_xor<1>(amx)); amx = fmaxf(amx, swz_xor<2>(amx)); amx = fmaxf(amx, swz_xor<4>(amx)); amx = fmaxf(amx, swz_xor<8>(amx)); amx = fmaxf(amx, swz_xor<16>(amx)); amx = half_max(amx);
    amx = fmaxf(amx, 1e-30f);
    const float s = 127.0f / amx;
    o.x = q8pack(f[0], f[1], f[2], f[3], s); o.y = q8pack(f[4], f[5], f[6], f[7], s); o.z = q8pack(f[8], f[9], f[10], f[11], s); o.w = q8pack(f[12], f[13], f[14], f[15], s);
    return amx;
}
__device__ __forceinline__ void ph_quant(const bf16_t* __restrict__ W, unsigned char* __restrict__ Q, const size_t qstride, float* __restrict__ SC, const int n0, const int n1,
                                         const bf16_t* __restrict__ XB, const float* __restrict__ SSQ, unsigned char* __restrict__ XQ, float* __restrict__ XS, int gw, int ngw, int lane) {
    for (int n = n0 + 2 * gw; n < n1; n += 2 * ngw) {
        const bool two = n + 1 < n1;
        const u32x4* s0 = (const u32x4*)(W + (size_t)n * C::D) + 2 * lane; const u32x4* s1 = (const u32x4*)(W + (size_t)(two ? n + 1 : n) * C::D) + 2 * lane;
        const u32x4 a0 = s0[0], b0 = s0[1], a1 = s1[0], b1 = s1[1];
        u32x4 o0, o1; const float m0 = quant_row(a0, b0, o0), m1 = quant_row(a1, b1, o1);
        *((u32x4*)(Q + (size_t)n * qstride) + lane) = o0;
        if (lane == 0) SC[n] = m0 * (1.0f / 127.0f);
        if (two) { *((u32x4*)(Q + (size_t)(n + 1) * qstride) + lane) = o1; if (lane == 0) SC[n + 1] = m1 * (1.0f / 127.0f); }
    }
    for (int row = 4 * gw; row < C::T; row += 4 * ngw) {
        u32x4 a[4], b[4]; float rstd[4];
#pragma unroll
        for (int r = 0; r < 4; ++r) { const int rr = (row + r < C::T) ? row + r : row; const u32x4* src = (const u32x4*)(XB + (size_t)rr * C::D) + 2 * lane; a[r] = src[0]; b[r] = src[1]; rstd[r] = row_rstd16(SSQ, rr); }
#pragma unroll
        for (int r = 0; r < 4; ++r) {
            u32x4 o; const float amx = quant_row(a[r], b[r], o);
            if (row + r < C::T) { *((u32x4*)(XQ + (size_t)(row + r) * C::D) + lane) = o; if (lane == 0) XS[row + r] = amx * (1.0f / 127.0f) * rstd[r]; }
        }
    }
}
__device__ __forceinline__ void ph_final(const bf16_t* __restrict__ XB, float* __restrict__ out, const float* __restrict__ g, const float* __restrict__ SSQ, int gw, int ngw, int lane) {
    const f32x4* gr = (const f32x4*)g + lane;
    f32x4 gg[4];
#pragma unroll
    for (int j = 0; j < 4; ++j) gg[j] = gr[64 * j];
    for (int row = 2 * gw; row < C::T; row += 2 * ngw) {
        u32x2 w[2][4]; float rstd[2];
#pragma unroll
        for (int r = 0; r < 2; ++r) { const u32x2* br = (const u32x2*)(XB + (size_t)(row + r) * C::D) + lane;
#pragma unroll
            for (int j = 0; j < 4; ++j) w[r][j] = __builtin_nontemporal_load(br + 64 * j);
            rstd[r] = row_rstd16(SSQ, row + r); }
#pragma unroll
        for (int r = 0; r < 2; ++r) { f32x4* orow = (f32x4*)(out + (size_t)(row + r) * C::D) + lane;
#pragma unroll
            for (int j = 0; j < 4; ++j) { f32x4 o;
                o.x = __uint_as_float(w[r][j].x << 16) * rstd[r] * gg[j].x; o.y = __uint_as_float(w[r][j].x & 0xffff0000u) * rstd[r] * gg[j].y; o.z = __uint_as_float(w[r][j].y << 16) * rstd[r] * gg[j].z; o.w = __uint_as_float(w[r][j].y & 0xffff0000u) * rstd[r] * gg[j].w;
                __builtin_nontemporal_store(o, orow + 64 * j); } }
    }
}
__device__ __forceinline__ void transpose_item(const float* __restrict__ W, int K, int N, bf16_t* __restrict__ WT, int ldd, int koff, const float* __restrict__ scale, LAS float* scr, int item, int lane) {
    const int nblk = N / 32, kb = item / nblk, nb = item % nblk, k0 = 64 * kb, n0 = 32 * nb;
    float wv_[32];
    const float* wp_ = W + (size_t)(k0 + (lane >> 5)) * N + n0 + (lane & 31);
#pragma unroll
    for (int i = 0; i < 32; ++i) wv_[i] = __builtin_nontemporal_load(wp_ + (size_t)(2 * i) * N);
    const float sc0 = scale ? scale[k0 + (lane & 31) * 2] : 1.0f, sc1 = scale ? scale[k0 + (lane & 31) * 2 + 1] : 1.0f;
#pragma unroll
    for (int i = 0; i < 32; ++i) { const float se = __shfl(sc0, i), so = __shfl(sc1, i); scr[(2 * i + (lane >> 5)) * 33 + (lane & 31)] = wv_[i] * ((lane >> 5) ? so : se); }
    asm volatile("s_waitcnt lgkmcnt(0)" ::: "memory");
    const int c = lane & 7;
#pragma unroll
    for (int j = 0; j < 4; ++j) { const int n = (lane >> 3) + 8 * j; const LAS float* s = scr + (8 * c) * 33 + n;
        u32x4 o; o.x = pk2(s[0 * 33], s[1 * 33]); o.y = pk2(s[2 * 33], s[3 * 33]); o.z = pk2(s[4 * 33], s[5 * 33]); o.w = pk2(s[6 * 33], s[7 * 33]);
        *(u32x4*)(WT + (size_t)(n0 + n) * ldd + koff + k0 + 8 * c) = o; }
    asm volatile("s_waitcnt lgkmcnt(0)" ::: "memory");
}
struct ConvArgs { const float *w_in, *g_mix, *w_a, *w_b, *w_c, *w_d, *d_scale, *w_o, *w_ff1, *g_ff, *w_ff2; bf16_t *WinT, *WoutT, *WoT, *W1T, *W2T; };
__device__ __forceinline__ void ph_convert(const ConvArgs& a, LAS float* scr, int gw, int ngw, int lane) {
    constexpr int I_IN = (C::D / 64) * (C::DIN / 32), I_OUT = (256 / 64) * (C::D / 32), I_O = (C::D / 64) * (C::D / 32), I_1 = (C::D / 64) * (C::DFF / 32), I_2 = (C::DFF / 64) * (C::D / 32);
    constexpr int NITEMS = I_IN + 4 * I_OUT + I_O + I_1 + I_2;
    for (int it = gw; it < NITEMS; it += ngw) {
        int r = it;
        if (r < I_IN) { transpose_item(a.w_in, C::D, C::DIN, a.WinT, C::D, 0, a.g_mix, scr, r, lane); continue; } r -= I_IN;
        if (r < I_OUT) { transpose_item(a.w_a, 256, C::D, a.WoutT, C::D, 0, nullptr, scr, r, lane); continue; } r -= I_OUT;
        if (r < I_OUT) { transpose_item(a.w_b, 256, C::D, a.WoutT, C::D, 256, nullptr, scr, r, lane); continue; } r -= I_OUT;
        if (r < I_OUT) { transpose_item(a.w_c, 256, C::D, a.WoutT, C::D, 512, nullptr, scr, r, lane); continue; } r -= I_OUT;
        if (r < I_OUT) { transpose_item(a.w_d, 256, C::D, a.WoutT, C::D, 768, a.d_scale, scr, r, lane); continue; } r -= I_OUT;
        if (r < I_O) { transpose_item(a.w_o, C::D, C::D, a.WoT, C::D, 0, nullptr, scr, r, lane); continue; } r -= I_O;
        if (r < I_1) { transpose_item(a.w_ff1, C::D, C::DFF, a.W1T, C::D, 0, a.g_ff, scr, r, lane); continue; } r -= I_1;
        transpose_item(a.w_ff2, C::DFF, C::D, a.W2T, C::DFF, 0, nullptr, scr, r, lane);
    }
}
typedef float f32x16 __attribute__((ext_vector_type(16)));
typedef short v4i16_t __attribute__((ext_vector_type(4)));
__device__ __forceinline__ v4i16_t lds_tr16(LAS unsigned char* p) { return __builtin_amdgcn_ds_read_tr16_b64_v4i16((LAS v4i16_t*)p); }
__device__ __forceinline__ unsigned cvtpk(float lo, float hi) { return pk2(lo, hi); }
constexpr int ATT_VSTRIDE = 192, ATT_KSTRIDE = 144, ATT_KOFF = 32 * ATT_VSTRIDE, ATT_WAVE_LDS = ATT_KOFF + 32 * ATT_KSTRIDE;
__host__ __device__ constexpr int att_lpad(int g) { return g == 0 ? 96 : (g == 1 ? 160 : 64); }
__host__ __device__ constexpr int att_lsize(int g) { return 2 * att_lpad(g) + 160; }
__host__ __device__ constexpr int att_lshift(int g) { return g == 1 ? 5 : 30; }
__host__ __device__ constexpr int att_lphys(int g) { return att_lsize(g) + (att_lsize(g) >> att_lshift(g)) + 1; }
__host__ __device__ constexpr int att_lbase(int g) { return g == 0 ? 0 : (g == 1 ? att_lphys(0) : att_lphys(0) + att_lphys(1)); }
constexpr int ATT_LUT_BYTES = 4864, ATT_XS = 136, ATT_XA_OFF = ATT_LUT_BYTES, ATT_XL_OFF = ATT_XA_OFF + 256 * ATT_XS, ATT_W_OFF = ATT_XL_OFF + 1024;
static_assert(4 * (att_lbase(2) + att_lphys(2)) <= ATT_LUT_BYTES && ATT_W_OFF + 8 * ATT_WAVE_LDS <= 131072, "attention LDS");
__device__ __forceinline__ void ph_attn(const bf16_t* __restrict__ Z, const float* __restrict__ rel_bias, bf16_t* __restrict__ MIX, LAS unsigned char* lds, int wgi, int nwg, int tid, int wv) {
    const int lane = tid & 63, ql = lane & 31, hi = lane >> 5;
    LAS float* lut = (LAS float*)lds; LAS unsigned char* wlds = lds + ATT_W_OFF + wv * ATT_WAVE_LDS;
    LAS unsigned char* xa = lds + ATT_XA_OFF; LAS float* xl = (LAS float*)(lds + ATT_XL_OFF);
    const int tr_off = (4 * hi + ((lane & 15) >> 2)) * ATT_VSTRIDE + (((lane >> 4) & 1) * 16 + (lane & 3) * 4) * 2;
    for (int item = wgi; item < C::NB * 4 * 8; item += nwg) {
        const int bh = item >> 3, b = bh >> 2, hh = bh & 3, J = (item >> 1) & 3, h8 = item & 1;
        const size_t rowb = (size_t)b * C::S;
        __syncthreads();
        for (int i = tid; i < att_lsize(0) + att_lsize(1) + att_lsize(2); i += 512) {
            const int g = i < att_lsize(0) ? 0 : (i < att_lsize(0) + att_lsize(1) ? 1 : 2);
            const int li = i - (g == 0 ? 0 : (g == 1 ? att_lsize(0) : att_lsize(0) + att_lsize(1)));
            const int dl = li - (g == 0 ? att_lpad(0) : (g == 1 ? att_lpad(1) : att_lpad(2)));
            float v = -INFINITY;
            if (dl >= 0 && dl <= 128) v = rel_bias[t5_bucket(dl << (2 * g)) * 12 + g * 4 + hh] * 1.4426950408889634f;
            lut[(g == 0 ? att_lbase(0) : (g == 1 ? att_lbase(1) : att_lbase(2))) + li + (li >> (g == 0 ? att_lshift(0) : (g == 1 ? att_lshift(1) : att_lshift(2))))] = v;
        }
        __syncthreads();
        const int tqA = 512 * J + 16 * (4 * wv + (ql >> 3)) + 8 * h8 + (ql & 7), tA0 = 512 * J + 64 * wv + 8 * h8;
        const int t0 = 512 * J + 8 * h8 + wv, tqB = t0 + 16 * ql;
        const int tlA = (4 * wv + (ql >> 3)) * 8 + (ql & 7), tlB = ql * 8 + wv;
#pragma unroll 1
        for (int pass = 0; pass < 2; ++pass) {
            const int tq = pass == 0 ? tqA : tqB;
            float m_run = -1e30f, l_run = 0.f;
            f32x16 o0, o1;
#pragma unroll
            for (int r = 0; r < 16; ++r) { o0[r] = 0.f; o1[r] = 0.f; }
            bf16x8 qf[4], k1[4], v1[4];
#define ATT_LOADT(KN, VN, gg, kkt) do { const int ssh_ = 2 * (gg); const int rg_ = t0 & ((1 << ssh_) - 1); \
                _Pragma("unroll") for (int i_ = 0; i_ < 4; ++i_) { const int c_ = lane + 64 * i_; \
                    const bf16_t* rp_ = Z + (rowb + (size_t)((((kkt) * 32 + (c_ >> 3)) << ssh_) + rg_)) * 2304 + (gg) * 256 + hh * 64 + (c_ & 7) * 8; \
                    KN[i_] = *(const bf16x8*)(rp_ + 768); VN[i_] = *(const bf16x8*)(rp_ + 1536); } } while (0)
#define ATT_LOADQ(gg) do { const bf16_t* qp_ = Z + (rowb + (size_t)tq) * 2304 + (gg) * 256 + hh * 64 + 8 * hi; \
                _Pragma("unroll") for (int s_ = 0; s_ < 4; ++s_) qf[s_] = *(const bf16x8*)(qp_ + 16 * s_); } while (0)
#define ATT_MQ0(gg) ((gg) == 0 ? tA0 : (t0 >> (2 * (gg))))
#define ATT_SPAN(gg) ((gg) == 0 ? 55 : 31 * (16 >> (2 * (gg))))
#define ATT_KLO(gg) (((ATT_MQ0(gg) - 128) > 0 ? (ATT_MQ0(gg) - 128) : 0) >> 5)
#define ATT_KHI(gg) ((ATT_MQ0(gg) + ATT_SPAN(gg)) >> 5)
            const int gend = pass == 0 ? 1 : 3;
#define ATT_NEXT(gv, kv) do { if ((gv) < gend) { if ((kv) < ATT_KHI(gv)) ++(kv); else { ++(gv); if ((gv) < gend) (kv) = ATT_KLO(gv); } } } while (0)
            int g0_ = pass == 0 ? 0 : 1, kt0_ = ATT_KLO(g0_);
            int qg = g0_;
            ATT_LOADQ(qg);
            ATT_LOADT(k1, v1, g0_, kt0_);
            for (;;) {
                bf16x8 kf[4], vr[4];
#pragma unroll
                for (int s = 0; s < 4; ++s) { kf[s] = k1[s]; vr[s] = v1[s]; }
                const int cg = g0_, csh = 2 * g0_, ckt = kt0_;
                ATT_NEXT(g0_, kt0_);
                const bool more = g0_ < gend;
                asm volatile("s_waitcnt lgkmcnt(0)" ::: "memory");
#pragma unroll
                for (int i = 0; i < 4; ++i) { const int c = lane + 64 * i; *(LAS bf16x8*)(wlds + (c >> 3) * ATT_VSTRIDE + (c & 7) * 16) = vr[i]; *(LAS bf16x8*)(wlds + ATT_KOFF + (c >> 3) * ATT_KSTRIDE + (c & 7) * 16) = kf[i]; }
                if (more) ATT_LOADT(k1, v1, g0_, kt0_);
                asm volatile("s_waitcnt lgkmcnt(0)" ::: "memory");
                const int mq = tq >> csh;
                const int dtop = mq - (ckt * 32 + 4 * hi) - 27;
                const LAS float* lg = lut + (cg == 0 ? att_lbase(0) : (cg == 1 ? att_lbase(1) : att_lbase(2)));
                const int li0 = dtop + (cg == 0 ? att_lpad(0) : (cg == 1 ? att_lpad(1) : att_lpad(2))), lsh = cg == 0 ? att_lshift(0) : (cg == 1 ? att_lshift(1) : att_lshift(2));
                bf16x8 ka[4]; float bia[16]; v4i16_t av[2][4];
#pragma unroll
                for (int s = 0; s < 4; ++s) ka[s] = *(const LAS bf16x8*)(wlds + ATT_KOFF + ql * ATT_KSTRIDE + 32 * s + 16 * hi);
#pragma unroll
                for (int r = 0; r < 16; ++r) { const int li = li0 + 27 - ((r & 3) + 8 * (r >> 2)); bia[r] = lg[li + (li >> lsh)]; }
#pragma unroll
                for (int dt = 0; dt < 2; ++dt)
#pragma unroll
                    for (int j = 0; j < 4; ++j) av[dt][j] = lds_tr16(wlds + tr_off + dt * 64 + 8 * j * ATT_VSTRIDE);
                __builtin_amdgcn_sched_barrier(0);
                f32x16 sacc;
#pragma unroll
                for (int r = 0; r < 16; ++r) sacc[r] = 0.f;
#pragma unroll
                for (int s = 0; s < 4; ++s) sacc = __builtin_amdgcn_mfma_f32_32x32x16_bf16(ka[s], qf[s], sacc, 0, 0, 0);
                if (more && g0_ != qg) { qg = g0_; ATT_LOADQ(qg); }
                float mx = -INFINITY;
#pragma unroll
                for (int r = 0; r < 16; ++r) { sacc[r] += bia[r]; mx = fmaxf(mx, sacc[r]); }
                mx = half_max(mx);
                if (__any(mx > m_run)) {
                    const float m_new = fmaxf(m_run, mx), f = __builtin_amdgcn_exp2f(m_run - m_new);
                    m_run = m_new; l_run *= f;
#pragma unroll
                    for (int r = 0; r < 16; ++r) { o0[r] *= f; o1[r] *= f; }
                }
                float ps = 0.f;
#pragma unroll
                for (int r = 0; r < 16; ++r) { sacc[r] = __builtin_amdgcn_exp2f(sacc[r] - m_run); ps += sacc[r]; }
                l_run += ps;
                u32x4 pw0, pw1;
                pw0.x = cvtpk(sacc[0], sacc[1]); pw0.y = cvtpk(sacc[2], sacc[3]); pw0.z = cvtpk(sacc[4], sacc[5]); pw0.w = cvtpk(sacc[6], sacc[7]);
                pw1.x = cvtpk(sacc[8], sacc[9]); pw1.y = cvtpk(sacc[10], sacc[11]); pw1.z = cvtpk(sacc[12], sacc[13]); pw1.w = cvtpk(sacc[14], sacc[15]);
                const bf16x8 pb0 = __builtin_bit_cast(bf16x8, pw0), pb1 = __builtin_bit_cast(bf16x8, pw1);
                {
                    const bf16x8 va00 = (bf16x8){av[0][0][0], av[0][0][1], av[0][0][2], av[0][0][3], av[0][1][0], av[0][1][1], av[0][1][2], av[0][1][3]};
                    const bf16x8 va01 = (bf16x8){av[0][2][0], av[0][2][1], av[0][2][2], av[0][2][3], av[0][3][0], av[0][3][1], av[0][3][2], av[0][3][3]};
                    const bf16x8 va10 = (bf16x8){av[1][0][0], av[1][0][1], av[1][0][2], av[1][0][3], av[1][1][0], av[1][1][1], av[1][1][2], av[1][1][3]};
                    const bf16x8 va11 = (bf16x8){av[1][2][0], av[1][2][1], av[1][2][2], av[1][2][3], av[1][3][0], av[1][3][1], av[1][3][2], av[1][3][3]};
                    o0 = __builtin_amdgcn_mfma_f32_32x32x16_bf16(va00, pb0, o0, 0, 0, 0); o1 = __builtin_amdgcn_mfma_f32_32x32x16_bf16(va10, pb0, o1, 0, 0, 0);
                    o0 = __builtin_amdgcn_mfma_f32_32x32x16_bf16(va01, pb1, o0, 0, 0, 0); o1 = __builtin_amdgcn_mfma_f32_32x32x16_bf16(va11, pb1, o1, 0, 0, 0);
                }
                if (!more) break;
            }
#undef ATT_LOADT
#undef ATT_LOADQ
#undef ATT_MQ0
#undef ATT_SPAN
#undef ATT_KLO
#undef ATT_KHI
#undef ATT_NEXT
            const float lt = half_sum(l_run);
            if (pass == 0) {
                const float inv = 1.0f / lt;
                LAS unsigned char* xr = xa + tlA * ATT_XS + 8 * hi;
#pragma unroll
                for (int c4 = 0; c4 < 4; ++c4) {
                    u32x2 w0, w1;
                    w0.x = cvtpk(o0[4 * c4] * inv, o0[4 * c4 + 1] * inv); w0.y = cvtpk(o0[4 * c4 + 2] * inv, o0[4 * c4 + 3] * inv);
                    w1.x = cvtpk(o1[4 * c4] * inv, o1[4 * c4 + 1] * inv); w1.y = cvtpk(o1[4 * c4 + 2] * inv, o1[4 * c4 + 3] * inv);
                    *(LAS u32x2*)(xr + 16 * c4) = w0; *(LAS u32x2*)(xr + 64 + 16 * c4) = w1;
                }
                if (hi == 0) xl[tlA] = m_run + __builtin_amdgcn_logf(lt);
                __syncthreads();
            } else {
                const float la = xl[tlB], M = fmaxf(la, m_run), wa = __builtin_amdgcn_exp2f(la - M), wb = __builtin_amdgcn_exp2f(m_run - M), inv = 1.0f / (wa + wb * lt);
                const float ca = wa * inv, cb = wb * inv;
                const LAS unsigned char* xr = xa + tlB * ATT_XS + 8 * hi;
                bf16_t* op = MIX + (rowb + (size_t)tqB) * C::D + 512 + hh * 64 + 4 * hi;
#pragma unroll
                for (int c4 = 0; c4 < 4; ++c4) {
                    const u32x2 a0 = *(const LAS u32x2*)(xr + 16 * c4), a1 = *(const LAS u32x2*)(xr + 64 + 16 * c4);
                    u32x2 w0, w1;
                    w0.x = cvtpk(ca * __uint_as_float(a0.x << 16) + cb * o0[4 * c4], ca * __uint_as_float(a0.x & 0xffff0000u) + cb * o0[4 * c4 + 1]);
                    w0.y = cvtpk(ca * __uint_as_float(a0.y << 16) + cb * o0[4 * c4 + 2], ca * __uint_as_float(a0.y & 0xffff0000u) + cb * o0[4 * c4 + 3]);
                    w1.x = cvtpk(ca * __uint_as_float(a1.x << 16) + cb * o1[4 * c4], ca * __uint_as_float(a1.x & 0xffff0000u) + cb * o1[4 * c4 + 1]);
                    w1.y = cvtpk(ca * __uint_as_float(a1.y << 16) + cb * o1[4 * c4 + 2], ca * __uint_as_float(a1.y & 0xffff0000u) + cb * o1[4 * c4 + 3]);
                    *(u32x2*)(op + 8 * c4) = w0; *(u32x2*)(op + 32 + 8 * c4) = w1;
                }
            }
        }
    }
}
constexpr int MA_VS = 272;
__device__ __forceinline__ void ph_mixA(const bf16_t* __restrict__ ZA, const float* __restrict__ ln_g, const float* __restrict__ ln_b, const bf16_t* __restrict__ WSB, const float* __restrict__ WSUM, const float* __restrict__ bs,
                                        bf16_t* __restrict__ MIX, LAS unsigned char* lds, int wg, int nwg, int tid, int wv) {
    const int lane = tid & 63, fr = lane & 15, fq = lane >> 4;
    for (int item = wg; item < C::T / 64; item += nwg) {
        const int t0 = (item >> 1) * 128, h = item & 1;
        const int gl = wv >> 2, tq = wv & 3, g = 2 * h + gl;
        bf16x8 bfr[2][4]; u32x2 urv[2][4]; f32x4 lgv[4], lbv[4]; float bsv[2], wsum[2];
#pragma unroll
        for (int i = 0; i < 2; ++i) { const int tb = 16 * (tq + 4 * i), nks = ((tb + 15) >> 5) + 1;
#pragma unroll
            for (int ks = 0; ks < 4; ++ks) if (ks < nks) bfr[i][ks] = *(const bf16x8*)(WSB + ((size_t)(g * 128 + tb + fr) * 128 + 32 * ks + 8 * fq));
#pragma unroll
            for (int cb = 0; cb < 4; ++cb) urv[i][cb] = *(const u32x2*)(ZA + (size_t)(t0 + tb + fr) * 512 + g * 64 + cb * 16 + fq * 4);
            bsv[i] = bs[g * 128 + tb + fr]; wsum[i] = WSUM[g * 128 + tb + fr]; }
#pragma unroll
        for (int cb = 0; cb < 4; ++cb) { lgv[cb] = *(const f32x4*)(ln_g + g * 64 + cb * 16 + fq * 4); lbv[cb] = *(const f32x4*)(ln_b + g * 64 + cb * 16 + fq * 4); }
        __syncthreads();
        {
            const int s = tid >> 2, q = tid & 3;
            const u32x4* src = (const u32x4*)(ZA + (size_t)(t0 + s) * 512 + 256 + 64 * q);
            u32x4 raw[8]; float sum = 0.f, sq = 0.f;
#pragma unroll
            for (int i = 0; i < 8; ++i) raw[i] = src[i];
#pragma unroll
            for (int i = 0; i < 8; ++i)
#pragma unroll
                for (int e = 0; e < 4; ++e) { const float a = __uint_as_float(raw[i][e] << 16), b = __uint_as_float(raw[i][e] & 0xffff0000u); sum += a + b; sq += a * a + b * b; }
            sum += swz_xor<1>(sum); sq += swz_xor<1>(sq); sum += swz_xor<2>(sum); sq += swz_xor<2>(sq);
            const float mu = sum * (1.0f / 256.0f), var = fmaxf(sq * (1.0f / 256.0f) - mu * mu, 0.f), rs = rsqrtf(var + C::EPS);
            if ((q >> 1) == h) {
                LAS u32x4* dst = (LAS u32x4*)(lds + s * MA_VS + (q & 1) * 128);
#pragma unroll
                for (int i = 0; i < 8; ++i) { u32x4 w;
#pragma unroll
                    for (int e = 0; e < 4; ++e) w[e] = pk2((__uint_as_float(raw[i][e] << 16) - mu) * rs, (__uint_as_float(raw[i][e] & 0xffff0000u) - mu) * rs);
                    dst[i] = w; }
            }
        }
        __syncthreads();
        LAS unsigned char* trb = lds + (8 * fq + ((lane & 15) >> 2)) * MA_VS + (gl * 64 + (lane & 3) * 4) * 2;
#pragma unroll
        for (int i = 0; i < 2; ++i) {
            const int tb = 16 * (tq + 4 * i), nks = ((tb + 15) >> 5) + 1;
            f32x4 acc[4];
#pragma unroll
            for (int cb = 0; cb < 4; ++cb) acc[cb] = (f32x4){0.f, 0.f, 0.f, 0.f};
#pragma unroll
            for (int ks = 0; ks < 4; ++ks) if (ks < nks) {
#pragma unroll
                for (int cb = 0; cb < 4; ++cb) {
                    const v4i16_t a0 = lds_tr16(trb + ks * 32 * MA_VS + cb * 32), a1 = lds_tr16(trb + (ks * 32 + 4) * MA_VS + cb * 32);
                    const bf16x8 a = (bf16x8){a0[0], a0[1], a0[2], a0[3], a1[0], a1[1], a1[2], a1[3]};
                    acc[cb] = __builtin_amdgcn_mfma_f32_16x16x32_bf16(a, bfr[i][ks], acc[cb], 0, 0, 0);
                }
            }
            const int t = tb + fr;
#pragma unroll
            for (int cb = 0; cb < 4; ++cb) {
                const int ch = g * 64 + cb * 16 + fq * 4;
                const u32x2 ur = urv[i][cb];
                const float u0 = __uint_as_float(ur.x << 16), u1 = __uint_as_float(ur.x & 0xffff0000u), u2 = __uint_as_float(ur.y << 16), u3 = __uint_as_float(ur.y & 0xffff0000u);
                u32x2 w; w.x = pk2(u0 * (lgv[cb][0] * acc[cb][0] + lbv[cb][0] * wsum[i] + bsv[i]), u1 * (lgv[cb][1] * acc[cb][1] + lbv[cb][1] * wsum[i] + bsv[i])); w.y = pk2(u2 * (lgv[cb][2] * acc[cb][2] + lbv[cb][2] * wsum[i] + bsv[i]), u3 * (lgv[cb][3] * acc[cb][3] + lbv[cb][3] * wsum[i] + bsv[i]));
                *(u32x2*)(MIX + (size_t)(t0 + t) * C::D + ch) = w;
            }
        }
    }
    __syncthreads();
}
__device__ __forceinline__ void ph_mixB(const bf16_t* __restrict__ ZB, const float* __restrict__ cw, bf16_t* __restrict__ MIX, int gt, int ngt) {
    for (int idx = gt; idx < C::T * 32; idx += ngt) {
        const int t = idx >> 5, ch = (idx & 31) * 8, s = t & (C::S - 1);
        float acc[8];
#pragma unroll
        for (int e = 0; e < 8; ++e) acc[e] = 0.f;
#pragma unroll
        for (int j = 0; j < 3; ++j) {
            if (s + j - 2 >= 0) {
                const bf16_t* p = ZB + (size_t)(t + j - 2) * 768 + ch;
                const u32x4 cv = *(const u32x4*)(p + 256), xv = *(const u32x4*)(p + 512);
                const f32x4 w0 = *(const f32x4*)(cw + j * 256 + ch), w1 = *(const f32x4*)(cw + j * 256 + ch + 4);
#pragma unroll
                for (int e = 0; e < 4; ++e) {
                    acc[2 * e] += (e < 2 ? w0[2 * e] : w1[2 * e - 4]) * (__uint_as_float(cv[e] << 16) * __uint_as_float(xv[e] << 16));
                    acc[2 * e + 1] += (e < 2 ? w0[2 * e + 1] : w1[2 * e - 3]) * (__uint_as_float(cv[e] & 0xffff0000u) * __uint_as_float(xv[e] & 0xffff0000u));
                }
            }
        }
        const u32x4 bv = *(const u32x4*)(ZB + (size_t)t * 768 + ch);
        u32x4 o;
#pragma unroll
        for (int e = 0; e < 4; ++e) o[e] = pk2(__uint_as_float(bv[e] << 16) * acc[2 * e], __uint_as_float(bv[e] & 0xffff0000u) * acc[2 * e + 1]);
        *(u32x4*)(MIX + (size_t)t * C::D + 256 + ch) = o;
    }
}
constexpr int MD_RS = 144, MD_WAVE_LDS = 32 * MD_RS;
template <int GI> __device__ __forceinline__ void mixD_items(const bf16_t* __restrict__ ZD, const bf16_t* __restrict__ DWT, bf16_t* __restrict__ MIX, LAS unsigned char* wl, int blk0, int nblk, int lane) {
    constexpr int W = 2 << GI;
    const int fr = lane & 15, fq = lane >> 4;
    bf16x8 af[4][2];
#pragma unroll
    for (int eb = 0; eb < 4; ++eb)
#pragma unroll
        for (int ks = 0; ks < 2; ++ks) af[eb][ks] = *(const bf16x8*)(DWT + ((size_t)(GI * 64 + eb * 16 + fr) * 64 + 32 * ks + 8 * fq));
#define MD_LOAD(dst, bb) do { const int tb_ = (bb) * 16, sb_ = tb_ & (C::S - 1); _Pragma("unroll") for (int i = 0; i < 4; ++i) { const int c = lane + 64 * i, j = c >> 3; const int jj = j < 31 ? j : 30; \
        const int off = (sb_ - 15 + jj < 0) ? -sb_ : (jj - 15); dst[i] = *(const u32x4*)(ZD + (size_t)(tb_ + off) * 256 + GI * 64 + (c & 7) * 8); } } while (0)
    u32x4 nx[4];
    if (blk0 < C::T / 16) MD_LOAD(nx, blk0);
    for (int blk = blk0; blk < C::T / 16; blk += nblk) {
        const int tb = blk * 16, sb = tb & (C::S - 1);
        u32x4 cur[4];
#pragma unroll
        for (int i = 0; i < 4; ++i) cur[i] = nx[i];
        if (blk + nblk < C::T / 16) MD_LOAD(nx, blk + nblk);
        asm volatile("s_waitcnt lgkmcnt(0)" ::: "memory");
#pragma unroll
        for (int i = 0; i < 4; ++i) { const int c = lane + 64 * i, j = c >> 3; if (j < 31) *(LAS u32x4*)(wl + j * MD_RS + (c & 7) * 16) = cur[i]; }
        asm volatile("s_waitcnt lgkmcnt(0)" ::: "memory");
        const int s = sb + fr, cnt = (s + 1 < W) ? s + 1 : W; const float inv = 1.0f / (float)cnt;
        bf16x8 yb[2];
#pragma unroll
        for (int ks = 0; ks < 2; ++ks) {
            u32x4 zv[W];
#pragma unroll
            for (int j = 0; j < W; ++j) zv[j] = *(const LAS u32x4*)(wl + (15 + fr - j) * MD_RS + (4 * ks + fq) * 16);
            float sum[8];
#pragma unroll
            for (int e = 0; e < 8; ++e) sum[e] = 0.f;
#pragma unroll
            for (int j = 0; j < W; ++j) { const float wj = j < cnt ? 1.0f : 0.0f;
#pragma unroll
                for (int e = 0; e < 4; ++e) { sum[2 * e] += wj * __uint_as_float(zv[j][e] << 16); sum[2 * e + 1] += wj * __uint_as_float(zv[j][e] & 0xffff0000u); } }
            u32x4 yw;
#pragma unroll
            for (int e = 0; e < 4; ++e) yw[e] = pk2(sum[2 * e] * inv - __uint_as_float(zv[0][e] << 16), sum[2 * e + 1] * inv - __uint_as_float(zv[0][e] & 0xffff0000u));
            yb[ks] = __builtin_bit_cast(bf16x8, yw);
        }
#pragma unroll
        for (int eb = 0; eb < 4; ++eb) {
            f32x4 acc = (f32x4){0.f, 0.f, 0.f, 0.f};
            acc = __builtin_amdgcn_mfma_f32_16x16x32_bf16(af[eb][0], yb[0], acc, 0, 0, 0);
            acc = __builtin_amdgcn_mfma_f32_16x16x32_bf16(af[eb][1], yb[1], acc, 0, 0, 0);
            u32x2 o; o.x = pk2(acc[0], acc[1]); o.y = pk2(acc[2], acc[3]);
            *(u32x2*)(MIX + (size_t)(tb + fr) * C::D + 768 + GI * 64 + eb * 16 + fq * 4) = o;
        }
    }
#undef MD_LOAD
}
__device__ __forceinline__ void ph_mixD(const bf16_t* __restrict__ ZD, const bf16_t* __restrict__ DWT, bf16_t* __restrict__ MIX, LAS unsigned char* wl, int gw, int ngw, int lane) {
    const int gi = gw & 3, blk0 = gw >> 2, nblk = ngw >> 2;
    if (gi == 0) mixD_items<0>(ZD, DWT, MIX, wl, blk0, nblk, lane);
    else if (gi == 1) mixD_items<1>(ZD, DWT, MIX, wl, blk0, nblk, lane);
    else if (gi == 2) mixD_items<2>(ZD, DWT, MIX, wl, blk0, nblk, lane);
    else mixD_items<3>(ZD, DWT, MIX, wl, blk0, nblk, lane);
}
__device__ __forceinline__ void ph_convert_small(const float* __restrict__ a_ws, const float* __restrict__ d_w, bf16_t* __restrict__ WSB, bf16_t* __restrict__ DWT, float* __restrict__ WSUM, int gt, int ngt) {
    for (int i = gt; i < 4 * 128; i += ngt) { const float* wr_ = a_ws + (size_t)i * 128; const int t = i & 127; float a = 0.f; for (int s = 0; s <= t; ++s) a += bf2f((unsigned short)f2bf(wr_[s])); WSUM[i] = a; }
    for (int i = gt; i < 4 * 128 * 128; i += ngt) { const int s = i & 127, t = (i >> 7) & 127; WSB[i] = (bf16_t)(s <= t ? f2bf(a_ws[i]) : 0u); }
    for (int i = gt; i < 4 * 64 * 64; i += ngt) { const int d = i & 63, e = (i >> 6) & 63, gi = i >> 12; DWT[i] = (bf16_t)f2bf(d_w[(gi * 64 + d) * 64 + e]); }
}
__device__ __forceinline__ void build_rstd_table(const float* __restrict__ SSQ, int pm, LAS float* rtab, int tid) {
    const int r = tid >> 1, h = tid & 1;
    const f32x4* p = (const f32x4*)(SSQ + (size_t)(pm * 256 + r) * 16 + h * 8); const f32x4 a = p[0], b = p[1];
    float s = ((a.x + a.y) + (a.z + a.w)) + ((b.x + b.y) + (b.z + b.w));
    s += swz_xor<1>(s);
    if (h == 0) rtab[r] = rsqrtf(s * (1.0f / C::D) + C::EPS);
    __syncthreads();
}

__device__ __forceinline__ bool runs_phase(int lo, int hi, int k) { asm volatile("" : "+s"(lo), "+s"(hi)); return lo <= k && k < hi; }
constexpr int NPHASES = 19;
#ifndef PROBE_DUP_PHASE
#define PROBE_DUP_PHASE -1
#endif
#define NREP(kind) ((kind) == PROBE_DUP_PHASE ? 2 : 1)
struct Args { const float* in[20]; float* out; unsigned char* ws; int ph_lo, ph_hi, li, pad; };
__global__ void __launch_bounds__(512, 2) mk_fwd(Args args) {
    extern __shared__ __attribute__((aligned(16))) unsigned char lds_raw[];
    LAS unsigned char* lds = (LAS unsigned char*)lds_raw;
    const int tid0 = threadIdx.x, wave = __builtin_amdgcn_readfirstlane(tid0 >> 6);
    constexpr int G = 256;
    const int bx = blockIdx.x, vcu0 = (bx % 8) * (G / 8) + bx / 8;
    constexpr int ngw = G * 8, ngt = G * 512;
    unsigned char* ws = args.ws;
    unsigned* ctl = (unsigned*)(ws + C::WS_CTL);
    for (int u = tid0; u < (C::LDS_BYTES - C::LDSCTL_OFF) / 4; u += 512) ((LAS unsigned*)(lds + C::LDSCTL_OFF))[u] = 0u;
    __syncthreads();
    volatile LAS unsigned* MISC = (volatile LAS unsigned*)(lds + C::MISC_OFF);
    XcdBarrier bar = xcd_barrier_post(ctl + C::CW_BAR + args.li * XCD_BAR_WORDS, MISC + 8);
    const int lo = args.ph_lo, hi = args.ph_hi;

    LAS float* scr = (LAS float*)(lds + wave * 16384);
    float* X = args.out;
    float* const WSC = (float*)((unsigned char*)args.out + C::OUT_WSC); float* const XS = WSC + 16384;   unsigned char* const XQ = (unsigned char*)args.out + C::OUT_XQ; unsigned char* const WGQ = (unsigned char*)args.out + C::OUT_WGQ;
    bf16_t* const W2T_L1 = (bf16_t*)((unsigned char*)args.out + 32 * C::MiB);
    int p = 0;
#define RUNS(k) runs_phase(lo, hi, (k))
#define SEAM(k) do { if ((k) + 1 < hi) { xcd_barrier(bar); if (NREP(50) == 2) xcd_barrier(bar); } } while (0)
#define PHASE_BEGIN int lane; asm volatile("v_mbcnt_lo_u32_b32 %0, -1, 0\n\tv_mbcnt_hi_u32_b32 %0, -1, %0" : "=v"(lane)); int vcu = vcu0; asm volatile("" : "+s"(vcu)); const int tid = wave * 64 + lane, gt = vcu * 512 + tid, gw = vcu * 8 + wave; (void)gt; (void)gw; \
    GAS unsigned char* wsg_ = (GAS unsigned char*)ws; asm volatile("" : "+s"(wsg_)); unsigned char* wsp = (unsigned char*)wsg_; (void)wsp
#define P_SSQ ((float*)(wsp + C::WS_SSQ))
#define P_WINT ((bf16_t*)(wsp + C::WS_WIN))
#define P_WOUTT ((bf16_t*)(wsp + C::WS_WOUT))
#define P_WOT ((bf16_t*)(wsp + C::WS_WO))
#define P_W1T ((bf16_t*)(wsp + C::WS_W1))
#define P_W2T ((bf16_t*)(wsp + C::WS_W2))
#define P_XB ((bf16_t*)(wsp + C::WS_XB))
#define P_MIX ((bf16_t*)X)
#define P_ZA ((bf16_t*)(wsp + C::WS_ZA))
#define P_ZB ((bf16_t*)(wsp + C::WS_ZB))
#define P_ZQKV ((bf16_t*)(wsp + C::WS_ZQKV))
#define P_ZD ((bf16_t*)(wsp + C::WS_ZD))
#define P_WSB ((bf16_t*)(wsp + C::WS_WSB))
#define P_DWT ((bf16_t*)(wsp + C::WS_DWT))
#define P_WSUM ((float*)(wsp + C::WS_WSUM))
#define P_PART ((float*)(wsp + C::WS_PART))
#define P_G (wsp + C::WS_G)
#define P_MERGED ((bf16_t*)(wsp + C::WS_MERGED))
#define P_H ((bf16_t*)(wsp + C::WS_H))
    for (int l = 0; l < C::L; ++l) {
        if (l == 0 && RUNS(p)) {
            PHASE_BEGIN;
            _Pragma("unroll 1") for (int rep_ = 0; rep_ < NREP(0); ++rep_) {
            if (rep_) xcd_barrier(bar);
            if (l == 0) ph_prologue(args.in[0], P_XB, P_SSQ, gw, ngw, lane);
            ConvArgs ca{args.in[2] + (size_t)l * C::D * C::DIN, args.in[1] + l * C::D, args.in[7] + (size_t)l * 256 * C::D, args.in[9] + (size_t)l * 256 * C::D, args.in[11] + (size_t)l * 256 * C::D, args.in[14] + (size_t)l * 256 * C::D,
                        args.in[13] + l * 256, args.in[15] + (size_t)l * C::D * C::D, args.in[17] + (size_t)l * C::D * C::DFF, args.in[16] + l * C::D, args.in[18] + (size_t)l * C::DFF * C::D, P_WINT, P_WOUTT, P_WOT, P_W1T, P_W2T};
            ph_convert(ca, scr, gw, ngw, lane);
            ph_convert_small(args.in[5] + (size_t)l * 4 * 128 * 128, args.in[12] + (size_t)l * 4 * 64 * 64, P_WSB, P_DWT, P_WSUM, gt, ngt);
            }
            SEAM(p);
        }
        ++p;
        if (RUNS(p)) {
            PHASE_BEGIN;
            ph_quant(P_WINT, WGQ, (size_t)C::D, WSC, C::I8_N0, C::DIN, P_XB, P_SSQ, XQ, XS, gw, ngw, lane);
            if (NREP(70) == 2) { xcd_barrier(bar); PHASE_BEGIN; ph_quant(P_WINT, WGQ, (size_t)C::D, WSC, C::I8_N0, C::DIN, P_XB, P_SSQ, XQ, XS, gw, ngw, lane); }
            SEAM(p);
        }
        ++p;
        if (RUNS(p)) {
            PHASE_BEGIN;
            _Pragma("unroll 1") for (int rep_ = 0; rep_ < NREP(1); ++rep_) {
            if (rep_) xcd_barrier(bar);
            {
                pg8::Gemm g{P_XB, P_WINT, C::T, C::I8_N0, C::D, C::D, C::D}; pg8::StaticOrder S; S.init(C::T, C::I8_N0, G, bx);
                pg8::Unit u0; S.next(0, u0); LAS float* rtab = (LAS float*)(lds + C::RTAB_OFF); build_rstd_table(P_SSQ, u0.pm, rtab, tid);
                pg8::PartOrder S8; S8.init(bx, 10);
                { LAS float* ctab = (LAS float*)(lds + C::CTAB_OFF);
                  float cv[8]; float xv = 0.f;
                  _Pragma("unroll") for (int i_ = 0; i_ < 8; ++i_) cv[i_] = (i_ < S8.cnt && tid < 256) ? WSC[C::I8_N0 + S8.tile(i_) * 256 + tid] : 0.f;
                  if (tid < 256) xv = XS[S8.pm * 256 + tid];
                  _Pragma("unroll") for (int i_ = 0; i_ < 8; ++i_) if (i_ < S8.cnt && tid < 256) ctab[i_ * 256 + tid] = cv[i_];
                  if (tid < 256) ((LAS float*)(lds + C::XTAB_OFF))[tid] = xv; }
                pg8::EpiInproj E{P_SSQ, P_ZA, P_ZB, P_ZQKV, P_ZD, P_G, rtab, u0.pm, wsp};
                pg8::gemm_phase<pg8::EpiInproj, pg8::StaticOrder, true, true>(lds, g, S, E, wave);
            }
            {
                pg8::Gemm g{(const bf16_t*)XQ, (const bf16_t*)(WGQ + (size_t)C::I8_N0 * C::D), C::T, C::DIN - C::I8_N0, C::D / 2, C::D / 2, C::D / 2};
                pg8::PartOrder S8; S8.init(bx, 10);
                pg8::EpiInprojI8 E{P_ZA, P_ZB, P_ZQKV, P_ZD, P_G, (const LAS float*)(lds + C::CTAB_OFF), (const LAS float*)(lds + C::XTAB_OFF), wsp, C::I8_N0 / 256, S8.l0, S8.nl, S8.h0};
                pg8::gemm_phase<pg8::EpiInprojI8, pg8::PartOrder, true, true>(lds, g, S8, E, wave);
            }
            }
            SEAM(p);
        }
        ++p;
        if (RUNS(p)) {
            PHASE_BEGIN;
            _Pragma("unroll 1") for (int rep_ = 0; rep_ < NREP(2); ++rep_) {
            if (rep_) xcd_barrier(bar);
            ph_attn(P_ZQKV, args.in[10], P_MIX, lds, vcu, G, tid, wave);
            if (NREP(20) == 2) { PHASE_BEGIN; ph_attn(P_ZQKV, args.in[10], P_MIX, lds, vcu, G, tid, wave); }
            ph_mixB(P_ZB, args.in[8] + l * 3 * 256, P_MIX, gt, ngt);
            if (NREP(21) == 2) { PHASE_BEGIN; ph_mixB(P_ZB, args.in[8] + l * 3 * 256, P_MIX, gt, ngt); }
            ph_mixD(P_ZD, P_DWT, P_MIX, lds + ATT_W_OFF + wave * ATT_WAVE_LDS, gw, ngw, lane);
            if (NREP(22) == 2) { PHASE_BEGIN; ph_mixD(P_ZD, P_DWT, P_MIX, lds + ATT_W_OFF + wave * ATT_WAVE_LDS, gw, ngw, lane); }
            ph_mixA(P_ZA, args.in[3] + l * 256, args.in[4] + l * 256, P_WSB, P_WSUM, args.in[6] + l * 4 * 128, P_MIX, lds, vcu, G, tid, wave);
            if (NREP(23) == 2) { PHASE_BEGIN; ph_mixA(P_ZA, args.in[3] + l * 256, args.in[4] + l * 256, P_WSB, P_WSUM, args.in[6] + l * 4 * 128, P_MIX, lds, vcu, G, tid, wave); }
            }
            SEAM(p);
        }
        ++p;
        if (RUNS(p)) {
            PHASE_BEGIN;
            _Pragma("unroll 1") for (int rep_ = 0; rep_ < NREP(3); ++rep_) {
            if (rep_) xcd_barrier(bar);
            pg8::gemm_merge_phase(lds, P_MIX, P_WOUTT, P_G, P_MERGED, vcu, G, wave);
            }
            SEAM(p);
        }
        ++p;
        if (RUNS(p)) {
            PHASE_BEGIN;
            pg8::Gemm g{P_MERGED, P_WOT, C::T, C::D, C::D, C::D, C::D}; pg8::StaticOrder S; S.init(C::T, C::D, G, bx);
            pg8::EpiResid E{P_XB, P_SSQ};
            pg8::gemm_phase<pg8::EpiResid, pg8::StaticOrder, false, true>(lds, g, S, E, wave);
            if (NREP(4) == 2) { xcd_barrier(bar); PHASE_BEGIN; pg8::Gemm g2{P_MERGED, P_WOT, C::T, C::D, C::D, C::D, C::D}; pg8::EpiResid E2{(bf16_t*)(wsp + 184 * C::MiB), (float*)(wsp + 216 * C::MiB)};
                pg8::gemm_phase<pg8::EpiResid, pg8::StaticOrder, false, true>(lds, g2, S, E2, wave); }
            SEAM(p);
        }
        ++p;
        if (RUNS(p)) {
            PHASE_BEGIN;
            ph_quant(P_W1T, (unsigned char*)P_W1T, (size_t)C::D * 2, WSC + 8192, 0, C::DFF, P_XB, P_SSQ, XQ, XS, gw, ngw, lane);
            SEAM(p);
        }
        ++p;
        if (RUNS(p)) {
            PHASE_BEGIN;
            _Pragma("unroll 1") for (int rep_ = 0; rep_ < NREP(5); ++rep_) {
            if (rep_) xcd_barrier(bar);
            pg8::Gemm g{(const bf16_t*)XQ, P_W1T, C::T, C::DFF, C::D / 2, C::D / 2, C::D}; pg8::StaticOrder S; S.init(C::T, C::DFF, G, bx);
            { LAS float* ctab = (LAS float*)(lds + C::CTAB_OFF);
              float cv[4]; int sl[4]; float xv = 0.f; pg8::Unit u0; S.next(0, u0);
              _Pragma("unroll") for (int i_ = 0; i_ < 4; ++i_) { pg8::Unit ui; const bool ok = S.next(i_, ui); sl[i_] = ok ? (ui.pn >> 2) : -1; cv[i_] = (ok && tid < 256) ? WSC[8192 + ui.pn * 256 + tid] : 0.f; }
              if (tid < 256) xv = XS[u0.pm * 256 + tid];
              _Pragma("unroll") for (int i_ = 0; i_ < 4; ++i_) if (sl[i_] >= 0 && tid < 256) ctab[sl[i_] * 256 + tid] = cv[i_];
              if (tid < 256) ((LAS float*)(lds + C::XTAB_OFF))[tid] = xv; }
            __syncthreads();
            pg8::EpiFF1I8 E{P_H, (const LAS float*)(lds + C::CTAB_OFF), (const LAS float*)(lds + C::XTAB_OFF)};
            pg8::gemm_phase<pg8::EpiFF1I8, pg8::StaticOrder, true, true>(lds, g, S, E, wave);
            }
            SEAM(p);
        }
        ++p;
        if (RUNS(p)) {
            PHASE_BEGIN;
            pg8::Gemm g{P_H, l == 0 ? P_W2T : W2T_L1, C::T, C::D, C::DFF, C::DFF, C::DFF}; pg8::StaticOrder S; S.init(C::T, C::D, G, bx);
            pg8::EpiResid E{P_XB, P_SSQ};
            pg8::gemm_phase<pg8::EpiResid, pg8::StaticOrder, false, true>(lds, g, S, E, wave);
            if (l + 1 < C::L) {
                const int l1 = l + 1;
                PHASE_BEGIN;
                ConvArgs ca{args.in[2] + (size_t)l1 * C::D * C::DIN, args.in[1] + l1 * C::D, args.in[7] + (size_t)l1 * 256 * C::D, args.in[9] + (size_t)l1 * 256 * C::D, args.in[11] + (size_t)l1 * 256 * C::D, args.in[14] + (size_t)l1 * 256 * C::D,
                            args.in[13] + l1 * 256, args.in[15] + (size_t)l1 * C::D * C::D, args.in[17] + (size_t)l1 * C::D * C::DFF, args.in[16] + l1 * C::D, args.in[18] + (size_t)l1 * C::DFF * C::D, P_WINT, P_WOUTT, P_WOT, P_W1T, W2T_L1};
                ph_convert(ca, scr, gw, ngw, lane);
                ph_convert_small(args.in[5] + (size_t)l1 * 4 * 128 * 128, args.in[12] + (size_t)l1 * 4 * 64 * 64, P_WSB, P_DWT, P_WSUM, gt, ngt);
            }
            SEAM(p);
        }
        ++p;
    }
    if (RUNS(p)) { PHASE_BEGIN; ph_final(P_XB, X, args.in[19], P_SSQ, gw, ngw, lane); }
#undef RUNS
#undef SEAM
}

extern "C" void kernel_launch(void* const* d_in, const int* in_sizes, int n_in, void* d_out, int out_size, void* d_ws, size_t ws_size, hipStream_t stream) {
    static int grid = 0;
    if (grid == 0) {
        if (n_in != 20 || out_size != C::T * C::D || ws_size < C::WS_END) { fprintf(stderr, "kernel_launch: unexpected shapes (n_in %d out %d ws %zu)\n", n_in, out_size, ws_size); grid = -1; return; }
        int dev = 0, cus = 0, per_cu = 0;
        if (hipGetDevice(&dev) != hipSuccess || hipDeviceGetAttribute(&cus, hipDeviceAttributeMultiprocessorCount, dev) != hipSuccess) { grid = -1; return; }
        if (hipFuncSetAttribute((const void*)mk_fwd, hipFuncAttributeMaxDynamicSharedMemorySize, C::LDS_BYTES) != hipSuccess) { fprintf(stderr, "kernel_launch: hipFuncSetAttribute failed\n"); grid = -1; return; }
        if (hipOccupancyMaxActiveBlocksPerMultiprocessor(&per_cu, (const void*)mk_fwd, 512, C::LDS_BYTES) != hipSuccess || per_cu < 1) { fprintf(stderr, "kernel_launch: occupancy query says %d blocks per CU\n", per_cu); grid = -1; (void)hipGetLastError(); return; }
        if (cus != 256) { fprintf(stderr, "kernel_launch: built for a 256-CU device, found %d CUs\n", cus); grid = -1; return; }
        grid = cus;
    }
    if (grid < 0) return;
    (void)hipMemsetAsync((char*)d_ws + C::WS_CTL, 0, C::CTL_ZERO_BYTES, stream);
    Args a{};
    for (int i = 0; i < 20; ++i) a.in[i] = (const float*)d_in[i];
    a.out = (float*)d_out; a.ws = (unsigned char*)d_ws;
#ifndef MK_SPLIT
    a.ph_lo = 0; a.ph_hi = NPHASES; a.li = 0;
    hipLaunchKernelGGL(mk_fwd, dim3(grid), dim3(512), C::LDS_BYTES, stream, a);
#else
    for (int p = 0; p < NPHASES; ++p) { a.ph_lo = p; a.ph_hi = p + 1; a.li = p; hipLaunchKernelGGL(mk_fwd, dim3(grid), dim3(512), C::LDS_BYTES, stream, a); }
#endif
}
```

```cpp
#include <hip/hip_runtime.h>
#include <stdint.h>
#include <stdio.h>

namespace C {
constexpr int D = 1024, NB = 8, S = 2048, T = NB * S, L = 2;
constexpr int DIN = 7936, DFF = 4096;
constexpr float EPS = 1e-6f;
constexpr size_t MiB = 1u << 20;
constexpr size_t WS_CTL = 0, CTL_ZERO_BYTES = 256 * 1024;
constexpr size_t WS_SSQ = 1 * MiB;
constexpr size_t WS_WSB = 2 * MiB;
constexpr size_t WS_WSUM = 2 * MiB + 196608;
constexpr size_t WS_DWT = 2 * MiB + 131072;
constexpr size_t WS_WIN = 3 * MiB;
constexpr size_t WS_WOUT = WS_WIN + 15 * MiB + MiB / 2;
constexpr size_t WS_WO = WS_WOUT + 2 * MiB;
constexpr size_t WS_W1 = WS_WO + 2 * MiB;
constexpr size_t WS_W2 = WS_W1 + 8 * MiB;
constexpr size_t WS_XB = 40 * MiB;
constexpr size_t WS_ZA = 72 * MiB;
constexpr size_t WS_ZB = 88 * MiB;
constexpr size_t WS_ZQKV = 112 * MiB;
constexpr size_t WS_ZD = 184 * MiB;
constexpr size_t WS_G = 192 * MiB;
constexpr size_t WS_MERGED = 72 * MiB;
constexpr size_t WS_PART = 112 * MiB;
constexpr size_t WS_H = 112 * MiB;
constexpr size_t WS_END = 256 * MiB;
constexpr int CW_PANEL = 32768;
constexpr int CW_GMAX = 2048;
constexpr int I8_N0 = 1280;
constexpr size_t OUT_W2T1 = 32 * MiB, OUT_XQ = 40 * MiB, OUT_WGQ = 56 * MiB, OUT_WSC = 56 * MiB + (size_t)7936 * 1024;
constexpr int CW_BAR = 4096;
constexpr int RING_BYTES = 131072, LDSCTL_OFF = RING_BYTES, MISC_OFF = LDSCTL_OFF + 320, RTAB_OFF = RING_BYTES + 1024  , CTAB_OFF = RING_BYTES + 2048  , XTAB_OFF = CTAB_OFF + 8192  , LDS_BYTES = CTAB_OFF + 16384;
}
#define LAS __attribute__((address_space(3)))
#define GAS __attribute__((address_space(1)))
__device__ __forceinline__ float bf2f(unsigned short v) { return __uint_as_float((unsigned)v << 16); }
__device__ __forceinline__ unsigned f2bf(float f) { unsigned u = __float_as_uint(f); return (u + 0x7fffu + ((u >> 16) & 1u)) >> 16; }
typedef float f32x2_t_ __attribute__((ext_vector_type(2))); typedef __bf16 bf16x2_t_ __attribute__((ext_vector_type(2)));
__device__ __forceinline__ unsigned pk2(float lo, float hi) { const f32x2_t_ v = {lo, hi}; const bf16x2_t_ b = __builtin_convertvector(v, bf16x2_t_); return __builtin_bit_cast(unsigned, b); }
__device__ __forceinline__ float sigmoidf_(float x) { return __builtin_amdgcn_rcpf(1.0f + __builtin_amdgcn_exp2f(-1.4426950408889634f * x)); }
__device__ __forceinline__ float gelu_tanh(float x) { const float u = 0.7978845608028654f * (x + 0.044715f * x * x * x); return x * sigmoidf_(2.0f * u); }
template <int X> __device__ __forceinline__ float swz_xor(float v) { return __int_as_float(__builtin_amdgcn_ds_swizzle(__float_as_int(v), 0x1F | (X << 10))); }
__device__ __forceinline__ float half_sum(float v) { const auto r = __builtin_amdgcn_permlane32_swap(__float_as_uint(v), __float_as_uint(v), false, false); return __uint_as_float(r[0]) + __uint_as_float(r[1]); }
__device__ __forceinline__ float half_max(float v) { const auto r = __builtin_amdgcn_permlane32_swap(__float_as_uint(v), __float_as_uint(v), false, false); return fmaxf(__uint_as_float(r[0]), __uint_as_float(r[1])); }
__device__ __forceinline__ float wave_sum(float v) { v += swz_xor<1>(v); v += swz_xor<2>(v); v += swz_xor<4>(v); v += swz_xor<8>(v); v += swz_xor<16>(v); return half_sum(v); }
__device__ __forceinline__ int t5_bucket(int dist) {
    if (dist < 16) return dist;
    int k = 16;
    k += dist >= 22; k += dist >= 30; k += dist >= 40; k += dist >= 54; k += dist >= 73; k += dist >= 99; k += dist >= 134; k += dist >= 182;
    k += dist >= 246; k += dist >= 332; k += dist >= 450; k += dist >= 609; k += dist >= 825; k += dist >= 1117; k += dist >= 1513;
    return k;
}
__device__ __forceinline__ float row_rstd16(const float* SSQ, int row) {
    typedef float f4 __attribute__((ext_vector_type(4)));
    const f4* p = (const f4*)(SSQ + (size_t)row * 16); const f4 a = p[0], b = p[1], c = p[2], d = p[3];
    const float s = ((a.x + a.y) + (a.z + a.w)) + ((b.x + b.y) + (b.z + b.w)) + ((c.x + c.y) + (c.z + c.w)) + ((d.x + d.y) + (d.z + d.w));
    return rsqrtf(s * (1.0f / C::D) + C::EPS);
}
namespace pg8 {
#define PG8_LAS __attribute__((address_space(3)))
typedef unsigned short bf16_t;
typedef short bf16x8 __attribute__((ext_vector_type(8)));
typedef float f32x4 __attribute__((ext_vector_type(4)));
typedef unsigned u32x4 __attribute__((ext_vector_type(4)));
typedef int i32x4 __attribute__((ext_vector_type(4)));
constexpr int WCS = 64, BJS = 32;
constexpr int BM = 256, BK = 64, HALF = 128, HTB = HALF * BK * 2  , STAGE_BYTES = 8 * HTB, NXCD = 8, WGM = 8;

__host__ __device__ __forceinline__ int lds_byte(int r, int c) { const int st = (r >> 4) * 2 + (c >> 5), rr = r & 15, cc = c & 31, ob = rr * 64 + cc * 2; return st * 1024 + (ob ^ (((ob >> 9) & 1) << 5)); }
__host__ __device__ __forceinline__ void stage_rc(int b, int& R, int& C) { const int st = b / 1024, sb = b % 1024, swz = sb ^ (((sb >> 9) & 1) << 5); R = (st >> 1) * 16 + swz / 64; C = (st & 1) * 32 + (swz % 64) / 2; }
__host__ __device__ __forceinline__ int perm32(int rho) { const int n = rho >> 4, i = rho & 15; return 8 * (i >> 2) + 4 * n + (i & 3); }

struct Unit { int pm, pn, ko; };
struct Gemm { const bf16_t* A; const bf16_t* Bt; int M, N, K, lda, ldb; };

struct StaticOrder {
    int nM, nN, nwg, G, c;
    __host__ __device__ void init(int M, int N, int G_, int c_) { nM = M / BM; nN = N / BM; nwg = nM * nN; G = G_; c = c_; }
    __host__ __device__ bool next(int i, Unit& u) const {
        const long L = (long)i * G + c; if (L >= nwg) return false;
        int wgid = (int)L; { const int q = nwg / NXCD, r = nwg % NXCD, xcd = wgid % NXCD, off = wgid / NXCD; wgid = (xcd < r ? xcd * (q + 1) : r * (q + 1) + (xcd - r) * q) + off; }
        const int nig = WGM * nN, gid = wgid / nig, fm = gid * WGM, gsz = (nM - fm) < WGM ? (nM - fm) : WGM;
        u.pm = fm + ((wgid % nig) % gsz); u.pn = (wgid % nig) / gsz; u.ko = 0; return true;
    }
    __device__ __forceinline__ void a_ready(const Unit&) const {}
    __device__ __forceinline__ void done(const Unit&) const {}
};
struct PartOrder {
    int pm, l0, nl, h0, cnt;
    __host__ __device__ void init(int c, int NL) { const int x = c % NXCD, off = c / NXCD, gq = off / WGM; pm = x * WGM + off % WGM;
        if (gq == 0) { l0 = 0; nl = 1; h0 = NL; cnt = 5; } else { l0 = 1 + 3 * (gq - 1); nl = 3; h0 = NL + 4 + 4 * (gq - 1); cnt = 7; } }
    __host__ __device__ int tile(int i) const { return i < nl ? l0 + i : h0 + (i - nl); }
    __host__ __device__ int slot(int pn, int NL) const { return pn < NL ? pn - l0 : nl + pn - h0; }
    __host__ __device__ bool next(int i, Unit& u) const { if (i >= cnt) return false; u.pm = pm; u.pn = tile((((pm >> 3) ^ (pm >> 4)) & 1) ? cnt - 1 - i : i); u.ko = 0; return true; }
    __device__ __forceinline__ void a_ready(const Unit&) const {}
    __device__ __forceinline__ void done(const Unit&) const {}
};

__device__ __forceinline__ unsigned cvt_pk_bf16(float lo, float hi) { unsigned r; asm volatile("v_cvt_pk_bf16_f32 %0, %1, %2" : "=v"(r) : "v"(lo), "v"(hi)); return r; }
typedef float f32x2 __attribute__((ext_vector_type(2)));
struct EpiInproj {
    static constexpr bool PERM = true, AFTER_DRAIN = false, I8 = false; static constexpr bool KROT = false; static constexpr int NST = 16;
    const float* SSQ; bf16_t *za, *zb, *zqkv, *zd; unsigned char* g; const PG8_LAS float* rtab; int pm_tab; unsigned char* wsb;
    __device__ __forceinline__ void operator()(const f32x4 (&acc)[2][2][4][2], const Unit& u, int wr, int wc, int fr, int fq) const {
        const int row0 = u.pm * BM + wr * 64 + fr, pn = u.pn;
        bf16_t* base = za; int ldc = 512, colt = pn * 256, mode = 1;
        if (pn >= 15) { mode = 2; colt = (pn - 15) * 256; }
        else if (pn >= 14) { base = zd; ldc = 256; colt = 0; mode = 0; }
        else if (pn >= 5) { base = zqkv; ldc = 2304; colt = (pn - 5) * 256; mode = 0; }
        else if (pn >= 2) { base = zb; ldc = 768; colt = (pn - 2) * 256; mode = 0; }
        const int col0 = colt + wc * WCS + 8 * fq;
        const __amdgpu_buffer_rsrc_t wrs = __builtin_amdgcn_make_buffer_rsrc(wsb, 0, (int)C::WS_END, 0x00020000);
        const size_t boff = (size_t)((const unsigned char*)base - wsb), goff = (size_t)(g - wsb);
        const float qsc = (pn >= 5 && pn < 8) ? 0.18033688011112042f : 1.0f;
        float rs[8];
        if (u.pm == pm_tab) {
#pragma unroll
            for (int i = 0; i < 8; ++i) rs[i] = rtab[wr * 64 + fr + (i >> 2) * HALF + (i & 3) * 16];
        } else {
#pragma unroll
            for (int i = 0; i < 8; ++i) { const f32x4 t = *(const f32x4*)(SSQ + (size_t)(row0 + (i >> 2) * HALF + (i & 3) * 16) * 16 + fq * 4); rs[i] = (t[0] + t[1]) + (t[2] + t[3]); }
#pragma unroll
            for (int i = 0; i < 8; ++i) { float v = rs[i]; v += swz_xor<16>(v); v = half_sum(v); rs[i] = rsqrtf(v * (1.0f / C::D) + C::EPS); }
        }
#pragma unroll
        for (int ai = 0; ai < 2; ++ai)
#pragma unroll
            for (int m = 0; m < 4; ++m) {
                const int row = row0 + ai * HALF + m * 16; const float rstd = rs[ai * 4 + m] * qsc;
#pragma unroll
                for (int bj = 0; bj < 2; ++bj) {
                    f32x4 v0 = acc[ai][bj][m][0] * rstd, v1 = acc[ai][bj][m][1] * rstd;
                    if (mode == 2) {
                        unsigned lo = 0, hi = 0;
#pragma unroll
                        for (int e = 0; e < 4; ++e) { lo = __builtin_amdgcn_cvt_pk_u8_f32(__builtin_floorf(sigmoidf_(v0[e]) * 255.0f + 0.5f), e, lo); hi = __builtin_amdgcn_cvt_pk_u8_f32(__builtin_floorf(sigmoidf_(v1[e]) * 255.0f + 0.5f), e, hi); }
                        typedef unsigned u32x2 __attribute__((ext_vector_type(2)));
                        __builtin_amdgcn_raw_buffer_store_b64((u32x2){lo, hi}, wrs, (unsigned)(goff + (size_t)row * 4096 + col0 + bj * BJS), 0, 16);
                    } else {
                        if (mode == 1) {
                            const f32x4 p0 = (v0 * v0) * -0.10294324f + -2.3022082f, p1 = (v1 * v1) * -0.10294324f + -2.3022082f;
                            const f32x4 q0 = p0 * v0, q1 = p1 * v1;
                            f32x4 r0, r1;
#pragma unroll
                            for (int e = 0; e < 4; ++e) { r0[e] = __builtin_amdgcn_rcpf(1.0f + __builtin_amdgcn_exp2f(q0[e])); r1[e] = __builtin_amdgcn_rcpf(1.0f + __builtin_amdgcn_exp2f(q1[e])); }
                            v0 = v0 * r0; v1 = v1 * r1;
                        }
                        u32x4 w; w.x = cvt_pk_bf16(v0[0], v0[1]); w.y = cvt_pk_bf16(v0[2], v0[3]); w.z = cvt_pk_bf16(v1[0], v1[1]); w.w = cvt_pk_bf16(v1[2], v1[3]);
                        __builtin_amdgcn_raw_buffer_store_b128(w, wrs, (unsigned)(boff + ((size_t)row * ldc + col0 + bj * BJS) * 2), 0, 16);
                    }
                }
            }
    }
};
struct EpiInprojI8 {
    static constexpr bool PERM = true, AFTER_DRAIN = false, I8 = true; static constexpr bool KROT = false; static constexpr int NST = 16;
    bf16_t *za, *zb, *zqkv, *zd; unsigned char* g; const PG8_LAS float *ctab, *xtab; unsigned char* wsb; int pn_off, l0, nl, h0;
    __device__ __forceinline__ void operator()(const f32x4 (&acc)[2][2][4][2], const Unit& u, int wr, int wc, int fr, int fq) const {
        const int row0 = u.pm * BM + wr * 64 + fr, pn = u.pn + pn_off;
        bf16_t* base = za; int ldc = 512, colt = pn * 256, mode = 1;
        if (pn >= 15) { mode = 2; colt = (pn - 15) * 256; }
        else if (pn >= 14) { base = zd; ldc = 256; colt = 0; mode = 0; }
        else if (pn >= 5) { base = zqkv; ldc = 2304; colt = (pn - 5) * 256; mode = 0; }
        else if (pn >= 2) { base = zb; ldc = 768; colt = (pn - 2) * 256; mode = 0; }
        const int col0 = colt + wc * WCS + 8 * fq;
        const __amdgpu_buffer_rsrc_t wrs = __builtin_amdgcn_make_buffer_rsrc(wsb, 0, (int)C::WS_END, 0x00020000);
        const size_t boff = (size_t)((const unsigned char*)base - wsb), goff = (size_t)(g - wsb);
        const float qsc = (pn >= 5 && pn < 8) ? 0.18033688011112042f : 1.0f;
        float xs[8];
#pragma unroll
        for (int i = 0; i < 8; ++i) xs[i] = xtab[wr * 64 + fr + (i >> 2) * HALF + (i & 3) * 16];
#pragma unroll
        for (int bj = 0; bj < 2; ++bj) {
            const PG8_LAS float* cp = ctab + (u.pn < 10 ? u.pn - l0 : nl + u.pn - h0) * 256 + wc * WCS + 8 * fq + bj * BJS; const float cfs = (mode == 2) ? -1.4426950408889634f : qsc;
            const f32x4 cf0 = *(const PG8_LAS f32x4*)cp * cfs, cf1 = *(const PG8_LAS f32x4*)(cp + 4) * cfs;
#pragma unroll
            for (int ai = 0; ai < 2; ++ai)
#pragma unroll
                for (int m = 0; m < 4; ++m) {
                    const int row = row0 + ai * HALF + m * 16;
                    {
                    const i32x4 a0 = __builtin_bit_cast(i32x4, acc[ai][bj][m][0]), a1 = __builtin_bit_cast(i32x4, acc[ai][bj][m][1]);
                    const float xf = xs[ai * 4 + m]; f32x4 v0 = __builtin_convertvector(a0, f32x4) * (cf0 * xf), v1 = __builtin_convertvector(a1, f32x4) * (cf1 * xf);
                    if (mode == 2) {
                        f32x4 e0, e1, s0, s1;
#pragma unroll
                        for (int e = 0; e < 4; ++e) { e0[e] = __builtin_amdgcn_exp2f(v0[e]); e1[e] = __builtin_amdgcn_exp2f(v1[e]); }
                        const f32x4 d0 = e0 + 1.0f, d1 = e1 + 1.0f;
#pragma unroll
                        for (int e = 0; e < 4; ++e) { s0[e] = __builtin_amdgcn_rcpf(d0[e]); s1[e] = __builtin_amdgcn_rcpf(d1[e]); }
                        const u32x4 y0 = __builtin_bit_cast(u32x4, s0 * 255.0f + 8388608.0f), y1 = __builtin_bit_cast(u32x4, s1 * 255.0f + 8388608.0f);
                        const unsigned lo = __builtin_amdgcn_perm(y0[1], y0[0], 0x0c0c0400u) | __builtin_amdgcn_perm(y0[3], y0[2], 0x04000c0cu);
                        const unsigned hi = __builtin_amdgcn_perm(y1[1], y1[0], 0x0c0c0400u) | __builtin_amdgcn_perm(y1[3], y1[2], 0x04000c0cu);
                        typedef unsigned u32x2 __attribute__((ext_vector_type(2)));
                        __builtin_amdgcn_raw_buffer_store_b64((u32x2){lo, hi}, wrs, (unsigned)(goff + (size_t)row * 4096 + col0 + bj * BJS), 0, 0);
                    } else {
                        if (mode == 1) {
#pragma unroll
                            for (int e = 0; e < 4; ++e) { v0[e] = gelu_tanh(v0[e]); v1[e] = gelu_tanh(v1[e]); }
                        }
                        u32x4 w; w.x = cvt_pk_bf16(v0[0], v0[1]); w.y = cvt_pk_bf16(v0[2], v0[3]); w.z = cvt_pk_bf16(v1[0], v1[1]); w.w = cvt_pk_bf16(v1[2], v1[3]);
                        __builtin_amdgcn_raw_buffer_store_b128(w, wrs, (unsigned)(boff + ((size_t)row * ldc + col0 + bj * BJS) * 2), 0, 16);
                    }
                    }
                }
        }
    }
};
struct EpiFF1 {
    static constexpr bool PERM = true, AFTER_DRAIN = false, I8 = false; static constexpr bool KROT = false; static constexpr int NST = 16;
    const float* SSQ; bf16_t* H; const PG8_LAS float* rtab; int pm_tab;
    __device__ __forceinline__ void operator()(const f32x4 (&acc)[2][2][4][2], const Unit& u, int wr, int wc, int fr, int fq) const {
        const int row0 = u.pm * BM + wr * 64 + fr, col0 = u.pn * BM + wc * WCS + 8 * fq;
        const __amdgpu_buffer_rsrc_t hrs = __builtin_amdgcn_make_buffer_rsrc(H, 0, (int)((size_t)C::T * C::DFF * 2), 0x00020000);
        float rs[8];
        if (u.pm == pm_tab) {
#pragma unroll
            for (int i = 0; i < 8; ++i) rs[i] = rtab[wr * 64 + fr + (i >> 2) * HALF + (i & 3) * 16];
        } else {
#pragma unroll
            for (int i = 0; i < 8; ++i) { const f32x4 t = *(const f32x4*)(SSQ + (size_t)(row0 + (i >> 2) * HALF + (i & 3) * 16) * 16 + fq * 4); rs[i] = (t[0] + t[1]) + (t[2] + t[3]); }
#pragma unroll
            for (int i = 0; i < 8; ++i) { float v = rs[i]; v += swz_xor<16>(v); v = half_sum(v); rs[i] = rsqrtf(v * (1.0f / C::D) + C::EPS); }
        }
#pragma unroll
        for (int ai = 0; ai < 2; ++ai)
#pragma unroll
            for (int m = 0; m < 4; ++m) {
                const int row = row0 + ai * HALF + m * 16; const float rstd = rs[ai * 4 + m];
#pragma unroll
                for (int bj = 0; bj < 2; ++bj) {
                    f32x4 v0 = acc[ai][bj][m][0] * rstd, v1 = acc[ai][bj][m][1] * rstd;
#pragma unroll
                    for (int e = 0; e < 4; ++e) { const float a = fmaxf(v0[e], 0.f), b = fmaxf(v1[e], 0.f); v0[e] = a * a; v1[e] = b * b; }
                    u32x4 w; w.x = cvt_pk_bf16(v0[0], v0[1]); w.y = cvt_pk_bf16(v0[2], v0[3]); w.z = cvt_pk_bf16(v1[0], v1[1]); w.w = cvt_pk_bf16(v1[2], v1[3]);
                    __builtin_amdgcn_raw_buffer_store_b128(w, hrs, (unsigned)(((size_t)row * C::DFF + col0 + bj * BJS) * 2), 0, 16);
                }
            }
    }
};
struct EpiFF1I8 {
    static constexpr bool PERM = true, AFTER_DRAIN = false, I8 = true; static constexpr bool KROT = false; static constexpr int NST = 16;
    bf16_t* H; const PG8_LAS float *ctab, *xtab;
    __device__ __forceinline__ void operator()(const f32x4 (&acc)[2][2][4][2], const Unit& u, int wr, int wc, int fr, int fq) const {
        const int row0 = u.pm * BM + wr * 64 + fr, col0 = u.pn * BM + wc * WCS + 8 * fq;
        const __amdgpu_buffer_rsrc_t hrs = __builtin_amdgcn_make_buffer_rsrc(H, 0, (int)((size_t)C::T * C::DFF * 2), 0x00020000);
        float xs[8];
#pragma unroll
        for (int i = 0; i < 8; ++i) xs[i] = xtab[wr * 64 + fr + (i >> 2) * HALF + (i & 3) * 16];
#pragma unroll
        for (int bj = 0; bj < 2; ++bj) {
            const PG8_LAS float* cp = ctab + (u.pn >> 2) * 256 + wc * WCS + 8 * fq + bj * BJS; const f32x4 cf0 = *(const PG8_LAS f32x4*)cp, cf1 = *(const PG8_LAS f32x4*)(cp + 4);
#pragma unroll
            for (int ai = 0; ai < 2; ++ai)
#pragma unroll
                for (int m = 0; m < 4; ++m) {
                    const int row = row0 + ai * HALF + m * 16;
                    const i32x4 a0 = __builtin_bit_cast(i32x4, acc[ai][bj][m][0]), a1 = __builtin_bit_cast(i32x4, acc[ai][bj][m][1]);
                    const float xf = xs[ai * 4 + m]; f32x4 v0 = __builtin_convertvector(a0, f32x4) * (cf0 * xf), v1 = __builtin_convertvector(a1, f32x4) * (cf1 * xf);
#pragma unroll
                    for (int e = 0; e < 4; ++e) { const float a = fmaxf(v0[e], 0.f), b = fmaxf(v1[e], 0.f); v0[e] = a * a; v1[e] = b * b; }
                    u32x4 w; w.x = cvt_pk_bf16(v0[0], v0[1]); w.y = cvt_pk_bf16(v0[2], v0[3]); w.z = cvt_pk_bf16(v1[0], v1[1]); w.w = cvt_pk_bf16(v1[2], v1[3]);
                    __builtin_amdgcn_raw_buffer_store_b128(w, hrs, (unsigned)(((size_t)row * C::DFF + col0 + bj * BJS) * 2), 0, 16);
                }
        }
    }
};
struct EpiResid {
    static constexpr bool PERM = true, AFTER_DRAIN = false, I8 = false; static constexpr bool KROT = true; static constexpr int NST = 0;
    bf16_t* XB; float* SSQ;
    __device__ __forceinline__ void operator()(const f32x4 (&acc)[2][2][4][2], const Unit& u, int wr, int wc, int fr, int fq) const {
        const int row0 = u.pm * BM + wr * 64 + fr, col0 = u.pn * BM + wc * WCS + 8 * fq;
        u32x4 xv[2][4][2];
#pragma unroll
        for (int ai = 0; ai < 2; ++ai)
#pragma unroll
            for (int m = 0; m < 4; ++m)
#pragma unroll
                for (int bj = 0; bj < 2; ++bj) xv[ai][m][bj] = *(const u32x4*)(XB + (size_t)(row0 + ai * HALF + m * 16) * C::D + col0 + bj * BJS);
        asm volatile("" ::: "memory");
#pragma unroll
        for (int ai = 0; ai < 2; ++ai)
#pragma unroll
            for (int m = 0; m < 4; ++m) {
                const int row = row0 + ai * HALF + m * 16; float ss = 0.f;
#pragma unroll
                for (int bj = 0; bj < 2; ++bj) {
                    const u32x4 xr = xv[ai][m][bj]; u32x4 w;
#pragma unroll
                    for (int q = 0; q < 4; ++q) {
                        const f32x4& a = acc[ai][bj][m][q >> 1];
                        const float y0 = __uint_as_float(xr[q] << 16) + a[2 * (q & 1)], y1 = __uint_as_float(xr[q] & 0xffff0000u) + a[2 * (q & 1) + 1];
                        w[q] = cvt_pk_bf16(y0, y1);
                        const float r0 = __uint_as_float(w[q] << 16), r1 = __uint_as_float(w[q] & 0xffff0000u);
                        ss += r0 * r0 + r1 * r1;
                    }
                    *(u32x4*)(XB + (size_t)row * C::D + col0 + bj * BJS) = w;
                }
                ss += swz_xor<16>(ss); ss = half_sum(ss);
                if (fq == 0) SSQ[(size_t)row * 16 + u.pn * 4 + wc] = ss;
            }
    }
};
template <bool I8> __device__ __forceinline__ f32x4 mma16(bf16x8 b, bf16x8 a, f32x4 c) {
    if constexpr (I8) return __builtin_bit_cast(f32x4, __builtin_amdgcn_mfma_i32_16x16x64_i8(__builtin_bit_cast(i32x4, b), __builtin_bit_cast(i32x4, a), __builtin_bit_cast(i32x4, c), 0, 0, 0));
    else return __builtin_amdgcn_mfma_f32_16x16x32_bf16(b, a, c, 0, 0, 0);
}
template <class Epi, class Sched, bool ALIGN_EPI = false, bool SP2 = false>
__device__ __forceinline__ void gemm_phase(PG8_LAS unsigned char* lds, const Gemm g, const Sched& S, const Epi& E, const int wid_in) {
    int lane; asm volatile("v_mbcnt_lo_u32_b32 %0, -1, 0\n\tv_mbcnt_hi_u32_b32 %0, -1, %0" : "=v"(lane));
    const int wid = wid_in, tid = wid * 64 + lane, wr = wid >> 2, wc = wid & 3, fr = lane & 15, fq = lane >> 4;
    const int K = g.K, nt = K / BK;
    unsigned voffA[2], voffB[2];
#pragma unroll
    for (int i = 0; i < 2; ++i) { int R, C; stage_rc(tid * 16 + i * 8192, R, C); const int Rb = Epi::PERM ? (WCS * (R >> 5) + perm32(R & 31)) : R;
        voffA[i] = (unsigned)(R * g.lda + C) * 2u; voffB[i] = (unsigned)(Rb * g.ldb + C) * 2u; }
    const size_t kstep = (size_t)(BK * 2);
    const size_t hstepA = (size_t)HALF * g.lda * 2, hstepB = (size_t)BJS * g.ldb * 2;
    const size_t tstepA = 2 * hstepA, tstepB = (size_t)BM * g.ldb * 2;
    const unsigned ldsw = (unsigned)wid * 1024u;
    const int aoff = lds_byte(wr * 64 + fr, fq * 8), boff = lds_byte(wc * 32 + fr, fq * 8);
#define PG8_SA(b, h) (((b) * 2 + (h)) * HTB)
#define PG8_SB(b, h) ((4 + (b) * 2 + (h)) * HTB)
#define PG8_STAGE(bufoff, gbase, voff) do { _Pragma("unroll") for (int _i = 0; _i < 2; ++_i) \
        __builtin_amdgcn_global_load_lds((const unsigned*)((const char*)(gbase) + (voff)[_i]), (PG8_LAS unsigned*)(lds + (bufoff) + ldsw + _i * 8192), 16, 0, 0); } while (0)
#define PG8_LDA(dst, b, h) do { _Pragma("unroll") for (int m = 0; m < 4; ++m) _Pragma("unroll") for (int k = 0; k < 2; ++k) dst[m][k] = *(const PG8_LAS bf16x8*)(lds + PG8_SA(b, h) + aoff + m * 2048 + k * 1024); } while (0)
#define PG8_LDB(dst, b, h) do { _Pragma("unroll") for (int n = 0; n < 2; ++n) _Pragma("unroll") for (int k = 0; k < 2; ++k) dst[n][k] = *(const PG8_LAS bf16x8*)(lds + PG8_SB(b, h) + boff + n * 2048 + k * 1024); } while (0)
#define PG8_MMA(ai, bj, At, Bt) do { __builtin_amdgcn_s_setprio(1); _Pragma("unroll") for (int m = 0; m < 4; ++m) _Pragma("unroll") for (int n = 0; n < 2; ++n) _Pragma("unroll") for (int k = 0; k < 2; ++k) \
        acc[ai][bj][m][n] = mma16<Epi::I8>(Bt[n][k], At[m][k], acc[ai][bj][m][n]); __builtin_amdgcn_s_setprio(0); } while (0)
#define PG8_WAIT_V(n) asm volatile("s_waitcnt vmcnt(" #n ")" ::: "memory")
#define PG8_WAIT_L(n) asm volatile("s_waitcnt lgkmcnt(" #n ")" ::: "memory")
#define PG8_BAR __builtin_amdgcn_s_barrier()
#define PG8_SCHED __builtin_amdgcn_sched_barrier(0)
    Unit cur, nxt; int ui = 0;
    if (!S.next(0, cur)) return;
    f32x4 acc[2][2][4][2];
#pragma unroll
    for (int a = 0; a < 2; ++a)
#pragma unroll
        for (int b = 0; b < 2; ++b)
#pragma unroll
            for (int m = 0; m < 4; ++m)
#pragma unroll
                for (int n = 0; n < 2; ++n) acc[a][b][m][n] = (f32x4){0.f, 0.f, 0.f, 0.f};
    bf16x8 At[4][2], B0[2][2], B1[2][2];
    const char* cA = (const char*)g.A + (size_t)cur.pm * tstepA + (size_t)cur.ko * 2; const char* cB = (const char*)g.Bt + (size_t)cur.pn * tstepB + (size_t)cur.ko * 2;
    int t0 = 0; if constexpr (Epi::KROT) t0 = ((cur.pm >> 3) & 1) ? nt / 2 : 0;
    const char* cA0 = cA + (size_t)t0 * kstep; const char* cB0 = cB + (size_t)t0 * kstep;
    S.a_ready(cur);
    if constexpr (SP2) {
        PG8_STAGE(PG8_SB(0, 0), cB0, voffB); PG8_STAGE(PG8_SB(0, 1), cB0 + hstepB, voffB); PG8_STAGE(PG8_SA(0, 0), cA0, voffA); PG8_STAGE(PG8_SA(0, 1), cA0 + hstepA, voffA);
        if (wr == 1) PG8_BAR;
        PG8_WAIT_V(2); PG8_BAR;
        PG8_STAGE(PG8_SB(1, 0), cB0 + kstep, voffB); PG8_STAGE(PG8_SA(1, 0), cA0 + kstep, voffA); PG8_STAGE(PG8_SB(1, 1), cB0 + hstepB + kstep, voffB);
        PG8_WAIT_V(6); PG8_BAR;
    } else {
        PG8_STAGE(PG8_SB(0, 0), cB, voffB); PG8_STAGE(PG8_SA(0, 0), cA, voffA); PG8_STAGE(PG8_SB(0, 1), cB + hstepB, voffB); PG8_STAGE(PG8_SA(0, 1), cA + hstepA, voffA);
        if (wr == 1) PG8_BAR;
        PG8_WAIT_V(4); PG8_BAR;
        PG8_STAGE(PG8_SB(1, 0), cB + kstep, voffB); PG8_STAGE(PG8_SA(1, 0), cA + kstep, voffA); PG8_STAGE(PG8_SB(1, 1), cB + hstepB + kstep, voffB);
        PG8_WAIT_V(6); PG8_BAR;
    }
    for (;;) {
        const bool has_next = S.next(ui + 1, nxt);
        const char* nA = has_next ? (const char*)g.A + (size_t)nxt.pm * tstepA + (size_t)nxt.ko * 2 : cA; const char* nB = has_next ? (const char*)g.Bt + (size_t)nxt.pn * tstepB + (size_t)nxt.ko * 2 : cB;
        for (int t = 0; t < nt; t += 2) {
            const bool last = (t == nt - 2);
            const int k0_ = (t + t0) & (nt - 1), k2_ = (t + 2 + t0) & (nt - 1);
            const char* a1 = cA + (size_t)(k0_ + 1) * kstep;
            const char* a2 = last ? nA : cA + (size_t)k2_ * kstep; const char* b2 = last ? nB : cB + (size_t)k2_ * kstep;
            const char* a3 = a2 + kstep; const char* b3 = b2 + kstep;
            if (last && has_next) S.a_ready(nxt);
            if constexpr (SP2) {
            PG8_LDB(B0, 0, 0); PG8_LDB(B1, 0, 1); PG8_SCHED; PG8_LDA(At, 0, 0); PG8_STAGE(PG8_SA(1, 1), a1 + hstepA, voffA);
            PG8_WAIT_V(8); PG8_WAIT_L(0); PG8_BAR; PG8_MMA(0, 0, At, B0); PG8_MMA(0, 1, At, B1); PG8_BAR; PG8_SCHED;
            PG8_LDA(At, 0, 1); PG8_STAGE(PG8_SB(0, 0), b2, voffB); PG8_STAGE(PG8_SB(0, 1), b2 + hstepB, voffB); PG8_STAGE(PG8_SA(0, 0), a2, voffA);
            PG8_WAIT_V(8); PG8_WAIT_L(0); PG8_BAR; PG8_MMA(1, 0, At, B0); PG8_MMA(1, 1, At, B1); PG8_BAR; PG8_SCHED;
            PG8_LDB(B0, 1, 0); PG8_LDB(B1, 1, 1); PG8_SCHED; PG8_LDA(At, 1, 0); PG8_STAGE(PG8_SA(0, 1), a2 + hstepA, voffA);
            PG8_WAIT_V(8); PG8_WAIT_L(0); PG8_BAR; PG8_MMA(0, 0, At, B0); PG8_MMA(0, 1, At, B1); PG8_BAR; PG8_SCHED;
            PG8_LDA(At, 1, 1); PG8_STAGE(PG8_SB(1, 0), b3, voffB); PG8_STAGE(PG8_SB(1, 1), b3 + hstepB, voffB); PG8_STAGE(PG8_SA(1, 0), a3, voffA);
            PG8_WAIT_V(8); PG8_WAIT_L(0); PG8_BAR; PG8_MMA(1, 0, At, B0); PG8_MMA(1, 1, At, B1); PG8_BAR; PG8_SCHED;
            } else {
            PG8_LDB(B0, 0, 0); PG8_SCHED; PG8_LDA(At, 0, 0); PG8_STAGE(PG8_SA(1, 1), a1 + hstepA, voffA);
            PG8_WAIT_L(8); PG8_BAR; PG8_WAIT_L(0); PG8_MMA(0, 0, At, B0); PG8_BAR; PG8_SCHED;
            PG8_LDB(B1, 0, 1); PG8_STAGE(PG8_SB(0, 0), b2, voffB);
            PG8_BAR; PG8_WAIT_L(0); PG8_MMA(0, 1, At, B1); PG8_BAR;
            PG8_LDA(At, 0, 1); PG8_STAGE(PG8_SA(0, 0), a2, voffA);
            PG8_BAR; PG8_WAIT_L(0); PG8_MMA(1, 0, At, B0); PG8_BAR; PG8_SCHED;
            PG8_STAGE(PG8_SB(0, 1), b2 + hstepB, voffB);
            PG8_WAIT_V(6); PG8_BAR; PG8_MMA(1, 1, At, B1); PG8_BAR;
            PG8_LDB(B0, 1, 0); PG8_SCHED; PG8_LDA(At, 1, 0); PG8_STAGE(PG8_SA(0, 1), a2 + hstepA, voffA);
            PG8_WAIT_L(8); PG8_BAR; PG8_WAIT_L(0); PG8_MMA(0, 0, At, B0); PG8_BAR; PG8_SCHED;
            PG8_LDB(B1, 1, 1); PG8_STAGE(PG8_SB(1, 0), b3, voffB);
            PG8_BAR; PG8_WAIT_L(0); PG8_MMA(0, 1, At, B1); PG8_BAR;
            PG8_LDA(At, 1, 1); PG8_STAGE(PG8_SA(1, 0), a3, voffA);
            PG8_BAR; PG8_WAIT_L(0); PG8_MMA(1, 0, At, B0); PG8_BAR; PG8_SCHED;
            PG8_STAGE(PG8_SB(1, 1), b3 + hstepB, voffB);
            PG8_WAIT_V(6); PG8_BAR; PG8_MMA(1, 1, At, B1); PG8_BAR;
            }
        }
        if constexpr (ALIGN_EPI) { if (wr == 0) PG8_BAR; }
        if constexpr (!Epi::AFTER_DRAIN) { E(acc, cur, wr, wc, fr, fq); S.done(cur); }
        if (!has_next) break;
#pragma unroll
        for (int a = 0; a < 2; ++a)
#pragma unroll
            for (int b = 0; b < 2; ++b)
#pragma unroll
                for (int m = 0; m < 4; ++m)
#pragma unroll
                    for (int n = 0; n < 2; ++n) acc[a][b][m][n] = (f32x4){0.f, 0.f, 0.f, 0.f};
        cur = nxt; cA = nA; cB = nB; ++ui;
        if constexpr (ALIGN_EPI) { if (wr == 1) PG8_BAR; }
    }
    PG8_WAIT_V(0);
    if constexpr (!ALIGN_EPI) { if (wr == 0) PG8_BAR; }
    PG8_BAR;
    if constexpr (Epi::AFTER_DRAIN) { E.fused(acc, cur, wr, wc, fr, fq, lds, wid, lane); S.done(cur); }
#undef PG8_SA
#undef PG8_SB
#undef PG8_STAGE
#undef PG8_LDA
#undef PG8_LDB
#undef PG8_MMA
#undef PG8_WAIT_V
#undef PG8_WAIT_L
#undef PG8_BAR
#undef PG8_SCHED
}
}
namespace pg8 {
__device__ __forceinline__ void gemm_merge_phase(PG8_LAS unsigned char* lds, const bf16_t* A, const bf16_t* Bt, const unsigned char* G, bf16_t* O, const int vcu, const int nwgs, const int wid_in) {
    int lane; asm volatile("v_mbcnt_lo_u32_b32 %0, -1, 0\n\tv_mbcnt_hi_u32_b32 %0, -1, %0" : "=v"(lane));
    const int wid = wid_in, tid = wid * 64 + lane, wr = wid >> 2, wc = wid & 3, fr = lane & 15, fq = lane >> 4;
    constexpr int K = C::D, nt = K / BK, LD = C::D;
    constexpr int NUNITS = (C::T / 256) * (C::D / 128);
    unsigned voffA[2], voffB[2];
#pragma unroll
    for (int i = 0; i < 2; ++i) { int R, Cc; stage_rc(tid * 16 + i * 8192, R, Cc); const int Rb = (R & ~31) + perm32(R & 31);
        voffA[i] = (unsigned)(R * LD + Cc) * 2u; voffB[i] = (unsigned)(Rb * LD + Cc) * 2u; }
    constexpr size_t kstep = (size_t)(BK * 2), hstep = (size_t)HALF * LD * 2;
    const unsigned ldsw = (unsigned)wid * 1024u;
    const int aoff = lds_byte(wr * 64 + fr, fq * 8), boff = lds_byte(wc * 32 + fr, fq * 8);
#define PG8_SA(b, h) (((b) * 2 + (h)) * HTB)
#define PG8_SB(b, h) ((4 + (b) * 2 + (h)) * HTB)
#define PG8_STAGE(bufoff, gbase, voff) do { _Pragma("unroll") for (int _i = 0; _i < 2; ++_i) \
        __builtin_amdgcn_global_load_lds((const unsigned*)((const char*)(gbase) + (voff)[_i]), (PG8_LAS unsigned*)(lds + (bufoff) + ldsw + _i * 8192), 16, 0, 0); } while (0)
#define PG8_LDA(dst, b, h) do { _Pragma("unroll") for (int m = 0; m < 4; ++m) _Pragma("unroll") for (int k = 0; k < 2; ++k) dst[m][k] = *(const PG8_LAS bf16x8*)(lds + PG8_SA(b, h) + aoff + m * 2048 + k * 1024); } while (0)
#define PG8_LDB(dst, b, h) do { _Pragma("unroll") for (int n = 0; n < 2; ++n) _Pragma("unroll") for (int k = 0; k < 2; ++k) dst[n][k] = *(const PG8_LAS bf16x8*)(lds + PG8_SB(b, h) + boff + n * 2048 + k * 1024); } while (0)
#define PG8_MMA(ai, At, Bt) do { __builtin_amdgcn_s_setprio(1); _Pragma("unroll") for (int m = 0; m < 4; ++m) _Pragma("unroll") for (int n = 0; n < 2; ++n) _Pragma("unroll") for (int k = 0; k < 2; ++k) \
        acc[ai][m][n] = __builtin_amdgcn_mfma_f32_16x16x32_bf16(Bt[n][k], At[m][k], acc[ai][m][n], 0, 0, 0); __builtin_amdgcn_s_setprio(0); } while (0)
#define PG8_WAIT_V(n) asm volatile("s_waitcnt vmcnt(" #n ")" ::: "memory")
#define PG8_WAIT_L(n) asm volatile("s_waitcnt lgkmcnt(" #n ")" ::: "memory")
#define PG8_BAR __builtin_amdgcn_s_barrier()
#define PG8_SCHED __builtin_amdgcn_sched_barrier(0)
    int L = vcu;
    if (L >= NUNITS) return;
    f32x4 acc[2][4][2], tot[2][4][2];
#pragma unroll
    for (int a = 0; a < 2; ++a)
#pragma unroll
        for (int m = 0; m < 4; ++m)
#pragma unroll
            for (int n = 0; n < 2; ++n) { acc[a][m][n] = (f32x4){0.f, 0.f, 0.f, 0.f}; tot[a][m][n] = (f32x4){0.f, 0.f, 0.f, 0.f}; }
    bf16x8 At[4][2], B0[2][2];
    const char* cA = (const char*)A + (size_t)(L >> 3) * (2 * hstep); const char* cB = (const char*)Bt + (size_t)(L & 7) * hstep;
    PG8_STAGE(PG8_SB(0, 0), cB, voffB); PG8_STAGE(PG8_SA(0, 0), cA, voffA); PG8_STAGE(PG8_SA(0, 1), cA + hstep, voffA);
    if (wr == 1) PG8_BAR;
    PG8_WAIT_V(2); PG8_BAR;
    PG8_STAGE(PG8_SB(1, 0), cB + kstep, voffB); PG8_STAGE(PG8_SA(1, 0), cA + kstep, voffA);
    PG8_WAIT_V(4); PG8_BAR;
    for (;;) {
        const int Ln = L + nwgs; const bool has_next = Ln < NUNITS;
        const char* nA = has_next ? (const char*)A + (size_t)(Ln >> 3) * (2 * hstep) : cA; const char* nB = has_next ? (const char*)Bt + (size_t)(Ln & 7) * hstep : cB;
        const int row0 = (L >> 3) * BM + wr * 64 + fr, col0 = (L & 7) * HALF + wc * 32 + 8 * fq;
#pragma unroll 1
        for (int seg = 0; seg < 4; ++seg) {
            typedef unsigned u32x2 __attribute__((ext_vector_type(2)));
            u32x2 gv[2][4];
            int r0g = row0; asm volatile("" : "+v"(r0g));
#pragma unroll
            for (int ai = 0; ai < 2; ++ai)
#pragma unroll
                for (int m = 0; m < 4; ++m) gv[ai][m] = *(const u32x2*)(G + (size_t)(r0g + ai * HALF + m * 16) * 4096 + seg * 1024 + col0);
#pragma unroll
            for (int h2 = 0; h2 < 2; ++h2) {
                const int t = seg * 4 + h2 * 2;
                const bool last = (t == nt - 2);
                const char* a1 = cA + (size_t)(t + 1) * kstep;
                const char* a2 = last ? nA : cA + (size_t)(t + 2) * kstep; const char* b2 = last ? nB : cB + (size_t)(t + 2) * kstep;
                const char* a3 = a2 + kstep; const char* b3 = b2 + kstep;
                PG8_LDB(B0, 0, 0); PG8_SCHED; PG8_LDA(At, 0, 0); PG8_STAGE(PG8_SA(1, 1), a1 + hstep, voffA);
                PG8_WAIT_V(6); PG8_WAIT_L(0); PG8_BAR; PG8_MMA(0, At, B0); PG8_BAR; PG8_SCHED;
                PG8_LDA(At, 0, 1); PG8_STAGE(PG8_SB(0, 0), b2, voffB); PG8_STAGE(PG8_SA(0, 0), a2, voffA);
                PG8_WAIT_V(6); PG8_WAIT_L(0); PG8_BAR; PG8_MMA(1, At, B0); PG8_BAR; PG8_SCHED;
                PG8_LDB(B0, 1, 0); PG8_SCHED; PG8_LDA(At, 1, 0); PG8_STAGE(PG8_SA(0, 1), a2 + hstep, voffA);
                PG8_WAIT_V(6); PG8_WAIT_L(0); PG8_BAR; PG8_MMA(0, At, B0); PG8_BAR; PG8_SCHED;
                PG8_LDA(At, 1, 1); PG8_STAGE(PG8_SB(1, 0), b3, voffB); PG8_STAGE(PG8_SA(1, 0), a3, voffA);
                PG8_WAIT_V(6); PG8_WAIT_L(0); PG8_BAR; PG8_MMA(1, At, B0); PG8_BAR; PG8_SCHED;
            }
#pragma unroll
            for (int ai = 0; ai < 2; ++ai)
#pragma unroll
                for (int m = 0; m < 4; ++m) {
                    const u32x2 gb = gv[ai][m];
#pragma unroll
                    for (int q = 0; q < 4; ++q) {
                        tot[ai][m][0][q] += (float)((gb.x >> (8 * q)) & 255u) * acc[ai][m][0][q];
                        tot[ai][m][1][q] += (float)((gb.y >> (8 * q)) & 255u) * acc[ai][m][1][q];
                    }
                    acc[ai][m][0] = (f32x4){0.f, 0.f, 0.f, 0.f}; acc[ai][m][1] = (f32x4){0.f, 0.f, 0.f, 0.f};
                }
        }
        int r0e = row0; asm volatile("" : "+v"(r0e));
#pragma unroll
        for (int ai = 0; ai < 2; ++ai)
#pragma unroll
            for (int m = 0; m < 4; ++m) {
                const f32x4 v0 = tot[ai][m][0] * (1.0f / 255.0f), v1 = tot[ai][m][1] * (1.0f / 255.0f);
                u32x4 w; w.x = cvt_pk_bf16(v0[0], v0[1]); w.y = cvt_pk_bf16(v0[2], v0[3]); w.z = cvt_pk_bf16(v1[0], v1[1]); w.w = cvt_pk_bf16(v1[2], v1[3]);
                *(u32x4*)(O + (size_t)(r0e + ai * HALF + m * 16) * C::D + col0) = w;
                tot[ai][m][0] = (f32x4){0.f, 0.f, 0.f, 0.f}; tot[ai][m][1] = (f32x4){0.f, 0.f, 0.f, 0.f};
            }
        if (!has_next) break;
        L = Ln; cA = nA; cB = nB;
    }
    PG8_WAIT_V(0);
    if (wr == 0) PG8_BAR;
    PG8_BAR;
#undef PG8_SA
#undef PG8_SB
#undef PG8_STAGE
#undef PG8_LDA
#undef PG8_LDB
#undef PG8_MMA
#undef PG8_WAIT_V
#undef PG8_WAIT_L
#undef PG8_BAR
#undef PG8_SCHED
}
}
#define XB_TMO      128
#define XB_XCNT(j)  (256  + 64 * (j))
#define XB_XSUB(j)  (1280 + 64 * (j))
#define XB_XGEN(j)  (2304 + 64 * (j))
#define XB_TOP      3328
#define XB_TOPGEN   3392
#define XCD_BAR_WORDS 3456
#define XB_SPIN_CAP (1u << 18)

__device__ __forceinline__ unsigned xb_ld(unsigned* p)              { return __hip_atomic_load(p, __ATOMIC_RELAXED, __HIP_MEMORY_SCOPE_AGENT); }
__device__ __forceinline__ unsigned xb_add(unsigned* p, unsigned v) { return __hip_atomic_fetch_add(p, v, __ATOMIC_RELAXED, __HIP_MEMORY_SCOPE_AGENT); }
__device__ __forceinline__ unsigned xb_xcc_id() { return (unsigned)__builtin_amdgcn_s_getreg((3 << 11) | 20) & 0xFu; }
#define XB_SPIN(cond, bar) do { unsigned _sp = 0; while (cond) { __builtin_amdgcn_s_sleep(1); \
    if ((++_sp & 255u) == 0u) { if (xb_ld(&(bar)[XB_TMO])) break; if (_sp > XB_SPIN_CAP) { atomicAdd(&(bar)[XB_TMO], 1u); break; } } } } while (0)

struct XcdBarrier {
    unsigned* bar; unsigned x;
    volatile LAS unsigned* st;
};

__device__ __forceinline__ XcdBarrier xcd_barrier_post(unsigned* bar, volatile LAS unsigned* st) {
    XcdBarrier b; b.bar = bar; b.x = xb_xcc_id(); b.st = st;
    if (threadIdx.x == 0) (void)xb_add(&bar[XB_XCNT(b.x)], 1u);
    return b;
}
__device__ __forceinline__ void xcd_barrier_complete(unsigned* bar, unsigned x, unsigned& nloc, unsigned& nx) {
    const unsigned G = gridDim.x * gridDim.y * gridDim.z;
    unsigned sum, cnt, mine, sp = 0u;
    for (;;) {
        sum = 0u; cnt = 0u; mine = 0u;
#pragma unroll
        for (unsigned j = 0; j < 16; ++j) { const unsigned c = xb_ld(&bar[XB_XCNT(j)]); sum += c; cnt += (c > 0u) ? 1u : 0u; mine = (j == x) ? c : mine; }
        if (sum == G) break;
        __builtin_amdgcn_s_sleep(1);
        if ((++sp & 255u) == 0u) { if (xb_ld(&bar[XB_TMO])) break; if (sp > XB_SPIN_CAP) { atomicAdd(&bar[XB_TMO], 1u); break; } }
    }
    nloc = mine > 0u ? mine : 1u; nx = cnt > 0u ? cnt : 1u;
}

__device__ __forceinline__ void xcd_barrier(const XcdBarrier& b) {
    asm volatile("s_waitcnt vmcnt(0)" ::: "memory");
    __syncthreads();
    if (threadIdx.x == 0) {
        unsigned* bar = b.bar;
        __builtin_amdgcn_s_waitcnt(0);
        unsigned nloc = b.st[0], nx = b.st[1];
        if (nloc == 0u) { xcd_barrier_complete(bar, b.x, nloc, nx); b.st[0] = nloc; b.st[1] = nx; }
        const unsigned old = xb_add(&bar[XB_XSUB(b.x)], 1u);
        const unsigned gen = old / nloc;
        if (old + 1u == (gen + 1u) * nloc) {
            __builtin_amdgcn_fence(__ATOMIC_RELEASE, "agent");
            asm volatile("s_waitcnt vmcnt(0)" ::: "memory");
            const unsigned og = xb_add(&bar[XB_TOP], 1u);
            const unsigned tg = og / nx;
            if (og + 1u == (tg + 1u) * nx) xb_add(&bar[XB_TOPGEN], 1u);
            else XB_SPIN(xb_ld(&bar[XB_TOPGEN]) == tg, bar);
            __builtin_amdgcn_fence(__ATOMIC_ACQUIRE, "agent");
            xb_add(&bar[XB_XGEN(b.x)], 1u);
            asm volatile("s_waitcnt vmcnt(0)" ::: "memory");
        } else {
            XB_SPIN(xb_ld(&bar[XB_XGEN(b.x)]) == gen, bar);
            __builtin_amdgcn_fence(__ATOMIC_ACQUIRE, "agent");
            asm volatile("s_waitcnt vmcnt(0)" ::: "memory");
        }
    }
    __syncthreads();
}
typedef unsigned short bf16_t;
typedef short bf16x8 __attribute__((ext_vector_type(8)));
typedef float f32x4 __attribute__((ext_vector_type(4)));
typedef unsigned u32x4 __attribute__((ext_vector_type(4)));
typedef unsigned u32x2 __attribute__((ext_vector_type(2)));

__device__ __forceinline__ unsigned q8pack(float a, float b, float c, float d, float s) {
    const float M = 12582912.0f;
    const unsigned ya = __float_as_uint(__builtin_fmaf(a, s, M)), yb = __float_as_uint(__builtin_fmaf(b, s, M)), yc = __float_as_uint(__builtin_fmaf(c, s, M)), yd = __float_as_uint(__builtin_fmaf(d, s, M));
    return __builtin_amdgcn_perm(yb, ya, 0x0c0c0400u) | __builtin_amdgcn_perm(yd, yc, 0x04000c0cu);
}
__device__ __forceinline__ void ph_prologue(const float* __restrict__ x, bf16_t* __restrict__ XB, float* __restrict__ SSQ, unsigned char* __restrict__ XQ, float* __restrict__ XS, int gw, int ngw, int lane) {
    for (int row = gw; row < C::T; row += ngw) {
        const f32x4* xr = (const f32x4*)(x + (size_t)row * C::D) + lane;
        u32x2* br = (u32x2*)(XB + (size_t)row * C::D) + lane;
        f32x4 v[4]; float s = 0.f, amx = 0.f;
#pragma unroll
        for (int j = 0; j < 4; ++j) v[j] = __builtin_nontemporal_load(xr + 64 * j);
#pragma unroll
        for (int j = 0; j < 4; ++j) { u32x2 w; w.x = pk2(v[j].x, v[j].y); w.y = pk2(v[j].z, v[j].w); br[64 * j] = w;
            const float a = __uint_as_float(w.x << 16), b = __uint_as_float(w.x & 0xffff0000u), c = __uint_as_float(w.y << 16), d = __uint_as_float(w.y & 0xffff0000u); s += (a * a + b * b) + (c * c + d * d);
            amx = fmaxf(fmaxf(amx, fmaxf(fabsf(a), fabsf(b))), fmaxf(fabsf(c), fabsf(d))); v[j] = (f32x4){a, b, c, d}; }
        s = wave_sum(s);
        if (lane < 4) { f32x4 o = {lane == 0 ? s : 0.f, 0.f, 0.f, 0.f}; *(f32x4*)(SSQ + (size_t)row * 16 + lane * 4) = o; }
        amx = fmaxf(amx, swz_xor<1>(amx)); amx = fmaxf(amx, swz_xor<2>(amx)); amx = fmaxf(amx, swz_xor<4>(amx)); amx = fmaxf(amx, swz_xor<8>(amx)); amx = fmaxf(amx, swz_xor<16>(amx)); amx = half_max(amx);
        amx = fmaxf(amx, 1e-30f);
        const float qs = 127.0f / amx;
        unsigned* qr = (unsigned*)(XQ + (size_t)row * C::D) + lane;
#pragma unroll
        for (int j = 0; j < 4; ++j) qr[64 * j] = q8pack(v[j].x, v[j].y, v[j].z, v[j].w, qs);
        if (lane == 0) XS[row] = amx * (1.0f / 127.0f) * rsqrtf(s * (1.0f / C::D) + C::EPS);
    }
}
__device__ __forceinline__ float quant_row(const u32x4 a, const u32x4 b, u32x4& o) {
    float f[16];
    f[0] = __uint_as_float(a.x << 16); f[1] = __uint_as_float(a.x & 0xffff0000u); f[2] = __uint_as_float(a.y << 16); f[3] = __uint_as_float(a.y & 0xffff0000u);
    f[4] = __uint_as_float(a.z << 16); f[5] = __uint_as_float(a.z & 0xffff0000u); f[6] = __uint_as_float(a.w << 16); f[7] = __uint_as_float(a.w & 0xffff0000u);
    f[8] = __uint_as_float(b.x << 16); f[9] = __uint_as_float(b.x & 0xffff0000u); f[10] = __uint_as_float(b.y << 16); f[11] = __uint_as_float(b.y & 0xffff0000u);
    f[12] = __uint_as_float(b.z << 16); f[13] = __uint_as_float(b.z & 0xffff0000u); f[14] = __uint_as_float(b.w << 16); f[15] = __uint_as_float(b.w & 0xffff0000u);
    float amx = 0.f;
#pragma unroll
    for (int i = 0; i < 16; ++i) amx = fmaxf(amx, fabsf(f[i]));
    amx = fmaxf(amx, swz_xor<1>(amx)); amx = fmaxf(amx, swz_xor<2>(amx)); amx = fmaxf(amx, swz_xor<4>(amx)); amx = fmaxf(amx, swz_xor<8>(amx)); amx = fmaxf(amx, swz_xor<16>(amx)); amx = half_max(amx);
    amx = fmaxf(amx, 1e-30f);
    const float s = 127.0f / amx;
    o.x = q8pack(f[0], f[1], f[2], f[3], s); o.y = q8pack(f[4], f[5], f[6], f[7], s); o.z = q8pack(f[8], f[9], f[10], f[11], s); o.w = q8pack(f[12], f[13], f[14], f[15], s);
    return amx;
}
__device__ __forceinline__ void ph_quant(const bf16_t* __restrict__ W, unsigned char* __restrict__ Q, const size_t qstride, float* __restrict__ SC, const int n0, const int n1,
                                         const bf16_t* __restrict__ XB, const float* __restrict__ SSQ, unsigned char* __restrict__ XQ, float* __restrict__ XS, const bool do_x, int gw, int ngw, int lane) {
    for (int n = n0 + 2 * gw; n < n1; n += 2 * ngw) {
        const bool two = n + 1 < n1;
        const u32x4* s0 = (const u32x4*)(W + (size_t)n * C::D) + 2 * lane; const u32x4* s1 = (const u32x4*)(W + (size_t)(two ? n + 1 : n) * C::D) + 2 * lane;
        const u32x4 a0 = s0[0], b0 = s0[1], a1 = s1[0], b1 = s1[1];
        u32x4 o0, o1; const float m0 = quant_row(a0, b0, o0), m1 = quant_row(a1, b1, o1);
        *((u32x4*)(Q + (size_t)n * qstride) + lane) = o0;
        if (lane == 0) SC[n] = m0 * (1.0f / 127.0f);
        if (two) { *((u32x4*)(Q + (size_t)(n + 1) * qstride) + lane) = o1; if (lane == 0) SC[n + 1] = m1 * (1.0f / 127.0f); }
    }
    if (do_x) for (int row = 4 * gw; row < C::T; row += 4 * ngw) {
        u32x4 a[4], b[4]; float rstd[4];
#pragma unroll
        for (int r = 0; r < 4; ++r) { const int rr = (row + r < C::T) ? row + r : row; const u32x4* src = (const u32x4*)(XB + (size_t)rr * C::D) + 2 * lane; a[r] = src[0]; b[r] = src[1]; rstd[r] = row_rstd16(SSQ, rr); }
#pragma unroll
        for (int r = 0; r < 4; ++r) {
            u32x4 o; const float amx = quant_row(a[r], b[r], o);
            if (row + r < C::T) { *((u32x4*)(XQ + (size_t)(row + r) * C::D) + lane) = o; if (lane == 0) XS[row + r] = amx * (1.0f / 127.0f) * rstd[r]; }
        }
    }
}
__device__ __forceinline__ void ph_final(const bf16_t* __restrict__ XB, float* __restrict__ out, const float* __restrict__ g, const float* __restrict__ SSQ, int gw, int ngw, int lane) {
    const f32x4* gr = (const f32x4*)g + lane;
    f32x4 gg[4];
#pragma unroll
    for (int j = 0; j < 4; ++j) gg[j] = gr[64 * j];
    for (int row = 2 * gw; row < C::T; row += 2 * ngw) {
        u32x2 w[2][4]; float rstd[2];
#pragma unroll
        for (int r = 0; r < 2; ++r) { const u32x2* br = (const u32x2*)(XB + (size_t)(row + r) * C::D) + lane;
#pragma unroll
            for (int j = 0; j < 4; ++j) w[r][j] = __builtin_nontemporal_load(br + 64 * j);
            rstd[r] = row_rstd16(SSQ, row + r); }
#pragma unroll
        for (int r = 0; r < 2; ++r) { f32x4* orow = (f32x4*)(out + (size_t)(row + r) * C::D) + lane;
#pragma unroll
            for (int j = 0; j < 4; ++j) { f32x4 o;
                o.x = __uint_as_float(w[r][j].x << 16) * rstd[r] * gg[j].x; o.y = __uint_as_float(w[r][j].x & 0xffff0000u) * rstd[r] * gg[j].y; o.z = __uint_as_float(w[r][j].y << 16) * rstd[r] * gg[j].z; o.w = __uint_as_float(w[r][j].y & 0xffff0000u) * rstd[r] * gg[j].w;
                __builtin_nontemporal_store(o, orow + 64 * j); } }
    }
}
__device__ __forceinline__ void transpose_item(const float* __restrict__ W, int K, int N, bf16_t* __restrict__ WT, int ldd, int koff, const float* __restrict__ scale, LAS float* scr, int item, int lane) {
    const int nblk = N / 32, kb = item / nblk, nb = item % nblk, k0 = 64 * kb, n0 = 32 * nb;
    float wv_[32];
    const float* wp_ = W + (size_t)(k0 + (lane >> 5)) * N + n0 + (lane & 31);
#pragma unroll
    for (int i = 0; i < 32; ++i) wv_[i] = __builtin_nontemporal_load(wp_ + (size_t)(2 * i) * N);
    const float sc0 = scale ? scale[k0 + (lane & 31) * 2] : 1.0f, sc1 = scale ? scale[k0 + (lane & 31) * 2 + 1] : 1.0f;
#pragma unroll
    for (int i = 0; i < 32; ++i) { const float se = __shfl(sc0, i), so = __shfl(sc1, i); scr[(2 * i + (lane >> 5)) * 33 + (lane & 31)] = wv_[i] * ((lane >> 5) ? so : se); }
    asm volatile("s_waitcnt lgkmcnt(0)" ::: "memory");
    const int c = lane & 7;
#pragma unroll
    for (int j = 0; j < 4; ++j) { const int n = (lane >> 3) + 8 * j; const LAS float* s = scr + (8 * c) * 33 + n;
        u32x4 o; o.x = pk2(s[0 * 33], s[1 * 33]); o.y = pk2(s[2 * 33], s[3 * 33]); o.z = pk2(s[4 * 33], s[5 * 33]); o.w = pk2(s[6 * 33], s[7 * 33]);
        *(u32x4*)(WT + (size_t)(n0 + n) * ldd + koff + k0 + 8 * c) = o; }
    asm volatile("s_waitcnt lgkmcnt(0)" ::: "memory");
}
struct ConvArgs { const float *w_in, *g_mix, *w_a, *w_b, *w_c, *w_d, *d_scale, *w_o, *w_ff1, *g_ff, *w_ff2; bf16_t *WinT, *WoutT, *WoT, *W1T, *W2T; };
__device__ __forceinline__ void ph_convert(const ConvArgs& a, LAS float* scr, int gw, int ngw, int lane) {
    constexpr int I_IN = (C::D / 64) * (C::DIN / 32), I_OUT = (256 / 64) * (C::D / 32), I_O = (C::D / 64) * (C::D / 32), I_1 = (C::D / 64) * (C::DFF / 32), I_2 = (C::DFF / 64) * (C::D / 32);
    constexpr int NITEMS = I_IN + 4 * I_OUT + I_O + I_1 + I_2;
    for (int it = gw; it < NITEMS; it += ngw) {
        int r = it;
        if (r < I_IN) { transpose_item(a.w_in, C::D, C::DIN, a.WinT, C::D, 0, a.g_mix, scr, r, lane); continue; } r -= I_IN;
        if (r < I_OUT) { transpose_item(a.w_a, 256, C::D, a.WoutT, C::D, 0, nullptr, scr, r, lane); continue; } r -= I_OUT;
        if (r < I_OUT) { transpose_item(a.w_b, 256, C::D, a.WoutT, C::D, 256, nullptr, scr, r, lane); continue; } r -= I_OUT;
        if (r < I_OUT) { transpose_item(a.w_c, 256, C::D, a.WoutT, C::D, 512, nullptr, scr, r, lane); continue; } r -= I_OUT;
        if (r < I_OUT) { transpose_item(a.w_d, 256, C::D, a.WoutT, C::D, 768, a.d_scale, scr, r, lane); continue; } r -= I_OUT;
        if (r < I_O) { transpose_item(a.w_o, C::D, C::D, a.WoT, C::D, 0, nullptr, scr, r, lane); continue; } r -= I_O;
        if (r < I_1) { transpose_item(a.w_ff1, C::D, C::DFF, a.W1T, C::D, 0, a.g_ff, scr, r, lane); continue; } r -= I_1;
        transpose_item(a.w_ff2, C::DFF, C::D, a.W2T, C::DFF, 0, nullptr, scr, r, lane);
    }
}
typedef float f32x16 __attribute__((ext_vector_type(16)));
typedef short v4i16_t __attribute__((ext_vector_type(4)));
__device__ __forceinline__ v4i16_t lds_tr16(LAS unsigned char* p) { return __builtin_amdgcn_ds_read_tr16_b64_v4i16((LAS v4i16_t*)p); }
__device__ __forceinline__ unsigned cvtpk(float lo, float hi) { return pk2(lo, hi); }
constexpr int ATT_VSTRIDE = 192, ATT_KSTRIDE = 144, ATT_KOFF = 32 * ATT_VSTRIDE, ATT_WAVE_LDS = ATT_KOFF + 32 * ATT_KSTRIDE;
__host__ __device__ constexpr int att_lpad(int g) { return g == 0 ? 96 : (g == 1 ? 160 : 64); }
__host__ __device__ constexpr int att_lsize(int g) { return 2 * att_lpad(g) + 160; }
__host__ __device__ constexpr int att_lshift(int g) { return g == 1 ? 5 : 30; }
__host__ __device__ constexpr int att_lphys(int g) { return att_lsize(g) + (att_lsize(g) >> att_lshift(g)) + 1; }
__host__ __device__ constexpr int att_lbase(int g) { return g == 0 ? 0 : (g == 1 ? att_lphys(0) : att_lphys(0) + att_lphys(1)); }
constexpr int ATT_LUT_BYTES = 4864, ATT_XS = 136, ATT_XA_OFF = ATT_LUT_BYTES, ATT_XL_OFF = ATT_XA_OFF + 256 * ATT_XS, ATT_W_OFF = ATT_XL_OFF + 1024;
static_assert(4 * (att_lbase(2) + att_lphys(2)) <= ATT_LUT_BYTES && ATT_W_OFF + 8 * ATT_WAVE_LDS <= 131072, "attention LDS");
__device__ __forceinline__ void ph_attn(const bf16_t* __restrict__ Z, const float* __restrict__ rel_bias, bf16_t* __restrict__ MIX, LAS unsigned char* lds, int wgi, int nwg, int tid, int wv) {
    const int lane = tid & 63, ql = lane & 31, hi = lane >> 5;
    LAS float* lut = (LAS float*)lds; LAS unsigned char* wlds = lds + ATT_W_OFF + wv * ATT_WAVE_LDS;
    LAS unsigned char* xa = lds + ATT_XA_OFF; LAS float* xl = (LAS float*)(lds + ATT_XL_OFF);
    const int tr_off = (4 * hi + ((lane & 15) >> 2)) * ATT_VSTRIDE + (((lane >> 4) & 1) * 16 + (lane & 3) * 4) * 2;
    for (int item = wgi; item < C::NB * 4 * 8; item += nwg) {
        const int bh = item >> 3, b = bh >> 2, hh = bh & 3, J = (item >> 1) & 3, h8 = item & 1;
        const size_t rowb = (size_t)b * C::S;
        __syncthreads();
        for (int i = tid; i < att_lsize(0) + att_lsize(1) + att_lsize(2); i += 512) {
            const int g = i < att_lsize(0) ? 0 : (i < att_lsize(0) + att_lsize(1) ? 1 : 2);
            const int li = i - (g == 0 ? 0 : (g == 1 ? att_lsize(0) : att_lsize(0) + att_lsize(1)));
            const int dl = li - (g == 0 ? att_lpad(0) : (g == 1 ? att_lpad(1) : att_lpad(2)));
            float v = -INFINITY;
            if (dl >= 0 && dl <= 128) v = rel_bias[t5_bucket(dl << (2 * g)) * 12 + g * 4 + hh] * 1.4426950408889634f;
            lut[(g == 0 ? att_lbase(0) : (g == 1 ? att_lbase(1) : att_lbase(2))) + li + (li >> (g == 0 ? att_lshift(0) : (g == 1 ? att_lshift(1) : att_lshift(2))))] = v;
        }
        __syncthreads();
        const int tqA = 512 * J + 16 * (4 * wv + (ql >> 3)) + 8 * h8 + (ql & 7), tA0 = 512 * J + 64 * wv + 8 * h8;
        const int t0 = 512 * J + 8 * h8 + wv, tqB = t0 + 16 * ql;
        const int tlA = (4 * wv + (ql >> 3)) * 8 + (ql & 7), tlB = ql * 8 + wv;
#pragma unroll 1
        for (int pass = 0; pass < 2; ++pass) {
            const int tq = pass == 0 ? tqA : tqB;
            float m_run = -1e30f, l_run = 0.f;
            f32x16 o0, o1;
#pragma unroll
            for (int r = 0; r < 16; ++r) { o0[r] = 0.f; o1[r] = 0.f; }
            bf16x8 qf[4], k1[4], v1[4];
#define ATT_LOADT(KN, VN, gg, kkt) do { const int ssh_ = 2 * (gg); const int rg_ = t0 & ((1 << ssh_) - 1); \
                _Pragma("unroll") for (int i_ = 0; i_ < 4; ++i_) { const int c_ = lane + 64 * i_; \
                    const bf16_t* rp_ = Z + (rowb + (size_t)((((kkt) * 32 + (c_ >> 3)) << ssh_) + rg_)) * 2304 + (gg) * 256 + hh * 64 + (c_ & 7) * 8; \
                    KN[i_] = *(const bf16x8*)(rp_ + 768); VN[i_] = *(const bf16x8*)(rp_ + 1536); } } while (0)
#define ATT_LOADQ(gg) do { const bf16_t* qp_ = Z + (rowb + (size_t)tq) * 2304 + (gg) * 256 + hh * 64 + 8 * hi; \
                _Pragma("unroll") for (int s_ = 0; s_ < 4; ++s_) qf[s_] = *(const bf16x8*)(qp_ + 16 * s_); } while (0)
#define ATT_MQ0(gg) ((gg) == 0 ? tA0 : (t0 >> (2 * (gg))))
#define ATT_SPAN(gg) ((gg) == 0 ? 55 : 31 * (16 >> (2 * (gg))))
#define ATT_KLO(gg) (((ATT_MQ0(gg) - 128) > 0 ? (ATT_MQ0(gg) - 128) : 0) >> 5)
#define ATT_KHI(gg) ((ATT_MQ0(gg) + ATT_SPAN(gg)) >> 5)
            const int gend = pass == 0 ? 1 : 3;
            int leftA = ATT_KHI(0) - ATT_KLO(0);
#define ATT_NEXT(gv, kv) do { if ((gv) < gend) { if (pass == 0) { if (leftA > 0) { --leftA; (kv) = ((kv) < ATT_KHI(0)) ? (kv) + 1 : ATT_KLO(0); } else (gv) = gend; } \
                else if ((kv) < ATT_KHI(gv)) ++(kv); else { ++(gv); if ((gv) < gend) (kv) = ATT_KLO(gv); } } } while (0)
            int g0_ = pass == 0 ? 0 : 1, kt0_ = ATT_KLO(g0_);
            if (pass == 0) { const int k6_ = ((ATT_KLO(0) + 5) / 6) * 6; if (k6_ <= ATT_KHI(0)) kt0_ = k6_; }
            int qg = g0_;
            ATT_LOADQ(qg);
            ATT_LOADT(k1, v1, g0_, kt0_);
            for (;;) {
                bf16x8 kf[4], vr[4];
#pragma unroll
                for (int s = 0; s < 4; ++s) { kf[s] = k1[s]; vr[s] = v1[s]; }
                const int cg = g0_, csh = 2 * g0_, ckt = kt0_;
                ATT_NEXT(g0_, kt0_);
                const bool more = g0_ < gend;
                asm volatile("s_waitcnt lgkmcnt(0)" ::: "memory");
#pragma unroll
                for (int i = 0; i < 4; ++i) { const int c = lane + 64 * i; *(LAS bf16x8*)(wlds + (c >> 3) * ATT_VSTRIDE + (c & 7) * 16) = vr[i]; *(LAS bf16x8*)(wlds + ATT_KOFF + (c >> 3) * ATT_KSTRIDE + (c & 7) * 16) = kf[i]; }
                if (more) ATT_LOADT(k1, v1, g0_, kt0_);
                asm volatile("s_waitcnt lgkmcnt(0)" ::: "memory");
                const int mq = tq >> csh;
                const int dtop = mq - (ckt * 32 + 4 * hi) - 27;
                const LAS float* lg = lut + (cg == 0 ? att_lbase(0) : (cg == 1 ? att_lbase(1) : att_lbase(2)));
                const int li0 = dtop + (cg == 0 ? att_lpad(0) : (cg == 1 ? att_lpad(1) : att_lpad(2))), lsh = cg == 0 ? att_lshift(0) : (cg == 1 ? att_lshift(1) : att_lshift(2));
                bf16x8 ka[4]; float bia[16]; v4i16_t av[2][4];
#pragma unroll
                for (int s = 0; s < 4; ++s) ka[s] = *(const LAS bf16x8*)(wlds + ATT_KOFF + ql * ATT_KSTRIDE + 32 * s + 16 * hi);
#pragma unroll
                for (int r = 0; r < 16; ++r) { const int li = li0 + 27 - ((r & 3) + 8 * (r >> 2)); bia[r] = lg[li + (li >> lsh)]; }
#pragma unroll
                for (int dt = 0; dt < 2; ++dt)
#pragma unroll
                    for (int j = 0; j < 4; ++j) av[dt][j] = lds_tr16(wlds + tr_off + dt * 64 + 8 * j * ATT_VSTRIDE);
                __builtin_amdgcn_sched_barrier(0);
                f32x16 sacc;
#pragma unroll
                for (int r = 0; r < 16; ++r) sacc[r] = 0.f;
#pragma unroll
                for (int s = 0; s < 4; ++s) sacc = __builtin_amdgcn_mfma_f32_32x32x16_bf16(ka[s], qf[s], sacc, 0, 0, 0);
                if (more && g0_ != qg) { qg = g0_; ATT_LOADQ(qg); }
                float mx = -INFINITY;
#pragma unroll
                for (int r = 0; r < 16; ++r) { sacc[r] += bia[r]; mx = fmaxf(mx, sacc[r]); }
                mx = half_max(mx);
                if (__any(mx > m_run)) {
                    const float m_new = fmaxf(m_run, mx), f = __builtin_amdgcn_exp2f(m_run - m_new);
                    m_run = m_new; l_run *= f;
#pragma unroll
                    for (int r = 0; r < 16; ++r) { o0[r] *= f; o1[r] *= f; }
                }
                float ps = 0.f;
#pragma unroll
                for (int r = 0; r < 16; ++r) { sacc[r] = __builtin_amdgcn_exp2f(sacc[r] - m_run); ps += sacc[r]; }
                l_run += ps;
                u32x4 pw0, pw1;
                pw0.x = cvtpk(sacc[0], sacc[1]); pw0.y = cvtpk(sacc[2], sacc[3]); pw0.z = cvtpk(sacc[4], sacc[5]); pw0.w = cvtpk(sacc[6], sacc[7]);
                pw1.x = cvtpk(sacc[8], sacc[9]); pw1.y = cvtpk(sacc[10], sacc[11]); pw1.z = cvtpk(sacc[12], sacc[13]); pw1.w = cvtpk(sacc[14], sacc[15]);
                const bf16x8 pb0 = __builtin_bit_cast(bf16x8, pw0), pb1 = __builtin_bit_cast(bf16x8, pw1);
                {
                    const bf16x8 va00 = (bf16x8){av[0][0][0], av[0][0][1], av[0][0][2], av[0][0][3], av[0][1][0], av[0][1][1], av[0][1][2], av[0][1][3]};
                    const bf16x8 va01 = (bf16x8){av[0][2][0], av[0][2][1], av[0][2][2], av[0][2][3], av[0][3][0], av[0][3][1], av[0][3][2], av[0][3][3]};
                    const bf16x8 va10 = (bf16x8){av[1][0][0], av[1][0][1], av[1][0][2], av[1][0][3], av[1][1][0], av[1][1][1], av[1][1][2], av[1][1][3]};
                    const bf16x8 va11 = (bf16x8){av[1][2][0], av[1][2][1], av[1][2][2], av[1][2][3], av[1][3][0], av[1][3][1], av[1][3][2], av[1][3][3]};
                    o0 = __builtin_amdgcn_mfma_f32_32x32x16_bf16(va00, pb0, o0, 0, 0, 0); o1 = __builtin_amdgcn_mfma_f32_32x32x16_bf16(va10, pb0, o1, 0, 0, 0);
                    o0 = __builtin_amdgcn_mfma_f32_32x32x16_bf16(va01, pb1, o0, 0, 0, 0); o1 = __builtin_amdgcn_mfma_f32_32x32x16_bf16(va11, pb1, o1, 0, 0, 0);
                }
                if (!more) break;
            }
#undef ATT_LOADT
#undef ATT_LOADQ
#undef ATT_MQ0
#undef ATT_SPAN
#undef ATT_KLO
#undef ATT_KHI
#undef ATT_NEXT
            const float lt = half_sum(l_run);
            if (pass == 0) {
                const float inv = 1.0f / lt;
                LAS unsigned char* xr = xa + tlA * ATT_XS + 8 * hi;
#pragma unroll
                for (int c4 = 0; c4 < 4; ++c4) {
                    u32x2 w0, w1;
                    w0.x = cvtpk(o0[4 * c4] * inv, o0[4 * c4 + 1] * inv); w0.y = cvtpk(o0[4 * c4 + 2] * inv, o0[4 * c4 + 3] * inv);
                    w1.x = cvtpk(o1[4 * c4] * inv, o1[4 * c4 + 1] * inv); w1.y = cvtpk(o1[4 * c4 + 2] * inv, o1[4 * c4 + 3] * inv);
                    *(LAS u32x2*)(xr + 16 * c4) = w0; *(LAS u32x2*)(xr + 64 + 16 * c4) = w1;
                }
                if (hi == 0) xl[tlA] = m_run + __builtin_amdgcn_logf(lt);
                __syncthreads();
            } else {
                const float la = xl[tlB], M = fmaxf(la, m_run), wa = __builtin_amdgcn_exp2f(la - M), wb = __builtin_amdgcn_exp2f(m_run - M), inv = 1.0f / (wa + wb * lt);
                const float ca = wa * inv, cb = wb * inv;
                const LAS unsigned char* xr = xa + tlB * ATT_XS + 8 * hi;
                bf16_t* op = MIX + (rowb + (size_t)tqB) * C::D + 512 + hh * 64 + 4 * hi;
#pragma unroll
                for (int c4 = 0; c4 < 4; ++c4) {
                    const u32x2 a0 = *(const LAS u32x2*)(xr + 16 * c4), a1 = *(const LAS u32x2*)(xr + 64 + 16 * c4);
                    u32x2 w0, w1;
                    w0.x = cvtpk(ca * __uint_as_float(a0.x << 16) + cb * o0[4 * c4], ca * __uint_as_float(a0.x & 0xffff0000u) + cb * o0[4 * c4 + 1]);
                    w0.y = cvtpk(ca * __uint_as_float(a0.y << 16) + cb * o0[4 * c4 + 2], ca * __uint_as_float(a0.y & 0xffff0000u) + cb * o0[4 * c4 + 3]);
                    w1.x = cvtpk(ca * __uint_as_float(a1.x << 16) + cb * o1[4 * c4], ca * __uint_as_float(a1.x & 0xffff0000u) + cb * o1[4 * c4 + 1]);
                    w1.y = cvtpk(ca * __uint_as_float(a1.y << 16) + cb * o1[4 * c4 + 2], ca * __uint_as_float(a1.y & 0xffff0000u) + cb * o1[4 * c4 + 3]);
                    *(u32x2*)(op + 8 * c4) = w0; *(u32x2*)(op + 32 + 8 * c4) = w1;
                }
            }
        }
    }
}
constexpr int MA_VS = 272;
__device__ __forceinline__ void ph_mixA(const bf16_t* __restrict__ ZA, const float* __restrict__ ln_g, const float* __restrict__ ln_b, const bf16_t* __restrict__ WSB, const float* __restrict__ WSUM, const float* __restrict__ bs,
                                        bf16_t* __restrict__ MIX, LAS unsigned char* lds, int wg, int nwg, int tid, int wv) {
    const int lane = tid & 63, fr = lane & 15, fq = lane >> 4;
    for (int item = wg; item < C::T / 64; item += nwg) {
        const int t0 = (item >> 1) * 128, h = item & 1;
        const int gl = wv >> 2, tq = wv & 3, g = 2 * h + gl;
        bf16x8 bfr[2][4]; u32x2 urv[2][4]; f32x4 lgv[4], lbv[4]; float bsv[2], wsum[2];
#pragma unroll
        for (int i = 0; i < 2; ++i) { const int tb = 16 * (tq + 4 * i), nks = ((tb + 15) >> 5) + 1;
#pragma unroll
            for (int ks = 0; ks < 4; ++ks) if (ks < nks) bfr[i][ks] = *(const bf16x8*)(WSB + ((size_t)(g * 128 + tb + fr) * 128 + 32 * ks + 8 * fq));
#pragma unroll
            for (int cb = 0; cb < 4; ++cb) urv[i][cb] = *(const u32x2*)(ZA + (size_t)(t0 + tb + fr) * 512 + g * 64 + cb * 16 + fq * 4);
            bsv[i] = bs[g * 128 + tb + fr]; wsum[i] = WSUM[g * 128 + tb + fr]; }
#pragma unroll
        for (int cb = 0; cb < 4; ++cb) { lgv[cb] = *(const f32x4*)(ln_g + g * 64 + cb * 16 + fq * 4); lbv[cb] = *(const f32x4*)(ln_b + g * 64 + cb * 16 + fq * 4); }
        __syncthreads();
        {
            const int s = tid >> 2, q = tid & 3;
            const u32x4* src = (const u32x4*)(ZA + (size_t)(t0 + s) * 512 + 256 + 64 * q);
            u32x4 raw[8]; float sum = 0.f, sq = 0.f;
#pragma unroll
            for (int i = 0; i < 8; ++i) raw[i] = src[i];
#pragma unroll
            for (int i = 0; i < 8; ++i)
#pragma unroll
                for (int e = 0; e < 4; ++e) { const float a = __uint_as_float(raw[i][e] << 16), b = __uint_as_float(raw[i][e] & 0xffff0000u); sum += a + b; sq += a * a + b * b; }
            sum += swz_xor<1>(sum); sq += swz_xor<1>(sq); sum += swz_xor<2>(sum); sq += swz_xor<2>(sq);
            const float mu = sum * (1.0f / 256.0f), var = fmaxf(sq * (1.0f / 256.0f) - mu * mu, 0.f), rs = rsqrtf(var + C::EPS);
            if ((q >> 1) == h) {
                LAS u32x4* dst = (LAS u32x4*)(lds + s * MA_VS + (q & 1) * 128);
#pragma unroll
                for (int i = 0; i < 8; ++i) { u32x4 w;
#pragma unroll
                    for (int e = 0; e < 4; ++e) w[e] = pk2((__uint_as_float(raw[i][e] << 16) - mu) * rs, (__uint_as_float(raw[i][e] & 0xffff0000u) - mu) * rs);
                    dst[i] = w; }
            }
        }
        __syncthreads();
        LAS unsigned char* trb = lds + (8 * fq + ((lane & 15) >> 2)) * MA_VS + (gl * 64 + (lane & 3) * 4) * 2;
#pragma unroll
        for (int i = 0; i < 2; ++i) {
            const int tb = 16 * (tq + 4 * i), nks = ((tb + 15) >> 5) + 1;
            f32x4 acc[4];
#pragma unroll
            for (int cb = 0; cb < 4; ++cb) acc[cb] = (f32x4){0.f, 0.f, 0.f, 0.f};
#pragma unroll
            for (int ks = 0; ks < 4; ++ks) if (ks < nks) {
#pragma unroll
                for (int cb = 0; cb < 4; ++cb) {
                    const v4i16_t a0 = lds_tr16(trb + ks * 32 * MA_VS + cb * 32), a1 = lds_tr16(trb + (ks * 32 + 4) * MA_VS + cb * 32);
                    const bf16x8 a = (bf16x8){a0[0], a0[1], a0[2], a0[3], a1[0], a1[1], a1[2], a1[3]};
                    acc[cb] = __builtin_amdgcn_mfma_f32_16x16x32_bf16(a, bfr[i][ks], acc[cb], 0, 0, 0);
                }
            }
            const int t = tb + fr;
#pragma unroll
            for (int cb = 0; cb < 4; ++cb) {
                const int ch = g * 64 + cb * 16 + fq * 4;
                const u32x2 ur = urv[i][cb];
                const float u0 = __uint_as_float(ur.x << 16), u1 = __uint_as_float(ur.x & 0xffff0000u), u2 = __uint_as_float(ur.y << 16), u3 = __uint_as_float(ur.y & 0xffff0000u);
                u32x2 w; w.x = pk2(u0 * (lgv[cb][0] * acc[cb][0] + lbv[cb][0] * wsum[i] + bsv[i]), u1 * (lgv[cb][1] * acc[cb][1] + lbv[cb][1] * wsum[i] + bsv[i])); w.y = pk2(u2 * (lgv[cb][2] * acc[cb][2] + lbv[cb][2] * wsum[i] + bsv[i]), u3 * (lgv[cb][3] * acc[cb][3] + lbv[cb][3] * wsum[i] + bsv[i]));
                *(u32x2*)(MIX + (size_t)(t0 + t) * C::D + ch) = w;
            }
        }
    }
    __syncthreads();
}
__device__ __forceinline__ void ph_mixB(const bf16_t* __restrict__ ZB, const float* __restrict__ cw, bf16_t* __restrict__ MIX, int gt, int ngt) {
    for (int idx = gt; idx < C::T * 32; idx += ngt) {
        const int t = idx >> 5, ch = (idx & 31) * 8, s = t & (C::S - 1);
        float acc[8];
#pragma unroll
        for (int e = 0; e < 8; ++e) acc[e] = 0.f;
#pragma unroll
        for (int j = 0; j < 3; ++j) {
            if (s + j - 2 >= 0) {
                const bf16_t* p = ZB + (size_t)(t + j - 2) * 768 + ch;
                const u32x4 cv = *(const u32x4*)(p + 256), xv = *(const u32x4*)(p + 512);
                const f32x4 w0 = *(const f32x4*)(cw + j * 256 + ch), w1 = *(const f32x4*)(cw + j * 256 + ch + 4);
#pragma unroll
                for (int e = 0; e < 4; ++e) {
                    acc[2 * e] += (e < 2 ? w0[2 * e] : w1[2 * e - 4]) * (__uint_as_float(cv[e] << 16) * __uint_as_float(xv[e] << 16));
                    acc[2 * e + 1] += (e < 2 ? w0[2 * e + 1] : w1[2 * e - 3]) * (__uint_as_float(cv[e] & 0xffff0000u) * __uint_as_float(xv[e] & 0xffff0000u));
                }
            }
        }
        const u32x4 bv = *(const u32x4*)(ZB + (size_t)t * 768 + ch);
        u32x4 o;
#pragma unroll
        for (int e = 0; e < 4; ++e) o[e] = pk2(__uint_as_float(bv[e] << 16) * acc[2 * e], __uint_as_float(bv[e] & 0xffff0000u) * acc[2 * e + 1]);
        *(u32x4*)(MIX + (size_t)t * C::D + 256 + ch) = o;
    }
}
constexpr int MD_RS = 144, MD_WAVE_LDS = 32 * MD_RS;
template <int GI> __device__ __forceinline__ void mixD_items(const bf16_t* __restrict__ ZD, const bf16_t* __restrict__ DWT, bf16_t* __restrict__ MIX, LAS unsigned char* wl, int blk0, int nblk, int lane) {
    constexpr int W = 2 << GI;
    const int fr = lane & 15, fq = lane >> 4;
    bf16x8 af[4][2];
#pragma unroll
    for (int eb = 0; eb < 4; ++eb)
#pragma unroll
        for (int ks = 0; ks < 2; ++ks) af[eb][ks] = *(const bf16x8*)(DWT + ((size_t)(GI * 64 + eb * 16 + fr) * 64 + 32 * ks + 8 * fq));
#define MD_LOAD(dst, bb) do { const int tb_ = (bb) * 16, sb_ = tb_ & (C::S - 1); _Pragma("unroll") for (int i = 0; i < 4; ++i) { const int c = lane + 64 * i, j = c >> 3; const int jj = j < 31 ? j : 30; \
        const int off = (sb_ - 15 + jj < 0) ? -sb_ : (jj - 15); dst[i] = *(const u32x4*)(ZD + (size_t)(tb_ + off) * 256 + GI * 64 + (c & 7) * 8); } } while (0)
    u32x4 nx[4];
    if (blk0 < C::T / 16) MD_LOAD(nx, blk0);
    for (int blk = blk0; blk < C::T / 16; blk += nblk) {
        const int tb = blk * 16, sb = tb & (C::S - 1);
        u32x4 cur[4];
#pragma unroll
        for (int i = 0; i < 4; ++i) cur[i] = nx[i];
        if (blk + nblk < C::T / 16) MD_LOAD(nx, blk + nblk);
        asm volatile("s_waitcnt lgkmcnt(0)" ::: "memory");
#pragma unroll
        for (int i = 0; i < 4; ++i) { const int c = lane + 64 * i, j = c >> 3; if (j < 31) *(LAS u32x4*)(wl + j * MD_RS + (c & 7) * 16) = cur[i]; }
        asm volatile("s_waitcnt lgkmcnt(0)" ::: "memory");
        const int s = sb + fr, cnt = (s + 1 < W) ? s + 1 : W; const float inv = 1.0f / (float)cnt;
        bf16x8 yb[2];
#pragma unroll
        for (int ks = 0; ks < 2; ++ks) {
            u32x4 zv[W];
#pragma unroll
            for (int j = 0; j < W; ++j) zv[j] = *(const LAS u32x4*)(wl + (15 + fr - j) * MD_RS + (4 * ks + fq) * 16);
            float sum[8];
#pragma unroll
            for (int e = 0; e < 8; ++e) sum[e] = 0.f;
#pragma unroll
            for (int j = 0; j < W; ++j) { const float wj = j < cnt ? 1.0f : 0.0f;
#pragma unroll
                for (int e = 0; e < 4; ++e) { sum[2 * e] += wj * __uint_as_float(zv[j][e] << 16); sum[2 * e + 1] += wj * __uint_as_float(zv[j][e] & 0xffff0000u); } }
            u32x4 yw;
#pragma unroll
            for (int e = 0; e < 4; ++e) yw[e] = pk2(sum[2 * e] * inv - __uint_as_float(zv[0][e] << 16), sum[2 * e + 1] * inv - __uint_as_float(zv[0][e] & 0xffff0000u));
            yb[ks] = __builtin_bit_cast(bf16x8, yw);
        }
#pragma unroll
        for (int eb = 0; eb < 4; ++eb) {
            f32x4 acc = (f32x4){0.f, 0.f, 0.f, 0.f};
            acc = __builtin_amdgcn_mfma_f32_16x16x32_bf16(af[eb][0], yb[0], acc, 0, 0, 0);
            acc = __builtin_amdgcn_mfma_f32_16x16x32_bf16(af[eb][1], yb[1], acc, 0, 0, 0);
            u32x2 o; o.x = pk2(acc[0], acc[1]); o.y = pk2(acc[2], acc[3]);
            *(u32x2*)(MIX + (size_t)(tb + fr) * C::D + 768 + GI * 64 + eb * 16 + fq * 4) = o;
        }
    }
#undef MD_LOAD
}
__device__ __forceinline__ void ph_mixD(const bf16_t* __restrict__ ZD, const bf16_t* __restrict__ DWT, bf16_t* __restrict__ MIX, LAS unsigned char* wl, int gw, int ngw, int lane) {
    const int gi = gw & 3, blk0 = gw >> 2, nblk = ngw >> 2;
    if (gi == 0) mixD_items<0>(ZD, DWT, MIX, wl, blk0, nblk, lane);
    else if (gi == 1) mixD_items<1>(ZD, DWT, MIX, wl, blk0, nblk, lane);
    else if (gi == 2) mixD_items<2>(ZD, DWT, MIX, wl, blk0, nblk, lane);
    else mixD_items<3>(ZD, DWT, MIX, wl, blk0, nblk, lane);
}
__device__ __forceinline__ void ph_convert_small(const float* __restrict__ a_ws, const float* __restrict__ d_w, bf16_t* __restrict__ WSB, bf16_t* __restrict__ DWT, float* __restrict__ WSUM, int gt, int ngt) {
    for (int i = gt; i < 4 * 128; i += ngt) { const float* wr_ = a_ws + (size_t)i * 128; const int t = i & 127; float a = 0.f; for (int s = 0; s <= t; ++s) a += bf2f((unsigned short)f2bf(wr_[s])); WSUM[i] = a; }
    for (int i = gt; i < 4 * 128 * 128; i += ngt) { const int s = i & 127, t = (i >> 7) & 127; WSB[i] = (bf16_t)(s <= t ? f2bf(a_ws[i]) : 0u); }
    for (int i = gt; i < 4 * 64 * 64; i += ngt) { const int d = i & 63, e = (i >> 6) & 63, gi = i >> 12; DWT[i] = (bf16_t)f2bf(d_w[(gi * 64 + d) * 64 + e]); }
}
__device__ __forceinline__ void build_rstd_table(const float* __restrict__ SSQ, int pm, LAS float* rtab, int tid) {
    const int r = tid >> 1, h = tid & 1;
    const f32x4* p = (const f32x4*)(SSQ + (size_t)(pm * 256 + r) * 16 + h * 8); const f32x4 a = p[0], b = p[1];
    float s = ((a.x + a.y) + (a.z + a.w)) + ((b.x + b.y) + (b.z + b.w));
    s += swz_xor<1>(s);
    if (h == 0) rtab[r] = rsqrtf(s * (1.0f / C::D) + C::EPS);
    __syncthreads();
}

__device__ __forceinline__ bool runs_phase(int lo, int hi, int k) { asm volatile("" : "+s"(lo), "+s"(hi)); return lo <= k && k < hi; }
constexpr int NPHASES = 19;
#ifndef PROBE_DUP_PHASE
#define PROBE_DUP_PHASE -1
#endif
#define NREP(kind) ((kind) == PROBE_DUP_PHASE ? 2 : 1)
struct Args { const float* in[20]; float* out; unsigned char* ws; int ph_lo, ph_hi, li, pad; };
__global__ void __launch_bounds__(512, 2) mk_fwd(Args args) {
    extern __shared__ __attribute__((aligned(16))) unsigned char lds_raw[];
    LAS unsigned char* lds = (LAS unsigned char*)lds_raw;
    const int tid0 = threadIdx.x, wave = __builtin_amdgcn_readfirstlane(tid0 >> 6);
    constexpr int G = 256;
    const int bx = blockIdx.x, vcu0 = (bx % 8) * (G / 8) + bx / 8;
    constexpr int ngw = G * 8, ngt = G * 512;
    unsigned char* ws = args.ws;
    unsigned* ctl = (unsigned*)(ws + C::WS_CTL);
    for (int u = tid0; u < (C::LDS_BYTES - C::LDSCTL_OFF) / 4; u += 512) ((LAS unsigned*)(lds + C::LDSCTL_OFF))[u] = 0u;
    __syncthreads();
    volatile LAS unsigned* MISC = (volatile LAS unsigned*)(lds + C::MISC_OFF);
    XcdBarrier bar = xcd_barrier_post(ctl + C::CW_BAR + args.li * XCD_BAR_WORDS, MISC + 8);
    const int lo = args.ph_lo, hi = args.ph_hi;

    LAS float* scr = (LAS float*)(lds + wave * 16384);
    float* X = args.out;
    float* const WSC = (float*)((unsigned char*)args.out + C::OUT_WSC); float* const XS = WSC + 16384;   unsigned char* const XQ = (unsigned char*)args.out + C::OUT_XQ; unsigned char* const WGQ = (unsigned char*)args.out + C::OUT_WGQ;
    bf16_t* const W2T_L1 = (bf16_t*)((unsigned char*)args.out + 32 * C::MiB);
    int p = 0;
#define RUNS(k) runs_phase(lo, hi, (k))
#define SEAM(k) do { if ((k) + 1 < hi) { xcd_barrier(bar); if (NREP(50) == 2) xcd_barrier(bar); } } while (0)
#define PHASE_BEGIN int lane; asm volatile("v_mbcnt_lo_u32_b32 %0, -1, 0\n\tv_mbcnt_hi_u32_b32 %0, -1, %0" : "=v"(lane)); int vcu = vcu0; asm volatile("" : "+s"(vcu)); const int tid = wave * 64 + lane, gt = vcu * 512 + tid, gw = vcu * 8 + wave; (void)gt; (void)gw; \
    GAS unsigned char* wsg_ = (GAS unsigned char*)ws; asm volatile("" : "+s"(wsg_)); unsigned char* wsp = (unsigned char*)wsg_; (void)wsp
#define P_SSQ ((float*)(wsp + C::WS_SSQ))
#define P_WINT ((bf16_t*)(wsp + C::WS_WIN))
#define P_WOUTT ((bf16_t*)(wsp + C::WS_WOUT))
#define P_WOT ((bf16_t*)(wsp + C::WS_WO))
#define P_W1T ((bf16_t*)(wsp + C::WS_W1))
#define P_W2T ((bf16_t*)(wsp + C::WS_W2))
#define P_XB ((bf16_t*)(wsp + C::WS_XB))
#define P_MIX ((bf16_t*)X)
#define P_ZA ((bf16_t*)(wsp + C::WS_ZA))
#define P_ZB ((bf16_t*)(wsp + C::WS_ZB))
#define P_ZQKV ((bf16_t*)(wsp + C::WS_ZQKV))
#define P_ZD ((bf16_t*)(wsp + C::WS_ZD))
#define P_WSB ((bf16_t*)(wsp + C::WS_WSB))
#define P_DWT ((bf16_t*)(wsp + C::WS_DWT))
#define P_WSUM ((float*)(wsp + C::WS_WSUM))
#define P_PART ((float*)(wsp + C::WS_PART))
#define P_G (wsp + C::WS_G)
#define P_MERGED ((bf16_t*)(wsp + C::WS_MERGED))
#define P_H ((bf16_t*)(wsp + C::WS_H))
    for (int l = 0; l < C::L; ++l) {
        if (l == 0 && RUNS(p)) {
            PHASE_BEGIN;
            _Pragma("unroll 1") for (int rep_ = 0; rep_ < NREP(0); ++rep_) {
            if (rep_) xcd_barrier(bar);
            if (l == 0) ph_prologue(args.in[0], P_XB, P_SSQ, XQ, XS, gw, ngw, lane);
            ConvArgs ca{args.in[2] + (size_t)l * C::D * C::DIN, args.in[1] + l * C::D, args.in[7] + (size_t)l * 256 * C::D, args.in[9] + (size_t)l * 256 * C::D, args.in[11] + (size_t)l * 256 * C::D, args.in[14] + (size_t)l * 256 * C::D,
                        args.in[13] + l * 256, args.in[15] + (size_t)l * C::D * C::D, args.in[17] + (size_t)l * C::D * C::DFF, args.in[16] + l * C::D, args.in[18] + (size_t)l * C::DFF * C::D, P_WINT, P_WOUTT, P_WOT, P_W1T, P_W2T};
            ph_convert(ca, scr, gw, ngw, lane);
            ph_convert_small(args.in[5] + (size_t)l * 4 * 128 * 128, args.in[12] + (size_t)l * 4 * 64 * 64, P_WSB, P_DWT, P_WSUM, gt, ngt);
            }
            SEAM(p);
        }
        ++p;
        if (RUNS(p)) {
            PHASE_BEGIN;
            ph_quant(P_WINT, WGQ, (size_t)C::D, WSC, C::I8_N0, C::DIN, P_XB, P_SSQ, XQ, XS, l > 0, gw, ngw, lane);
            if (NREP(70) == 2) { xcd_barrier(bar); PHASE_BEGIN; ph_quant(P_WINT, WGQ, (size_t)C::D, WSC, C::I8_N0, C::DIN, P_XB, P_SSQ, XQ, XS, l > 0, gw, ngw, lane); }
            SEAM(p);
        }
        ++p;
        if (RUNS(p)) {
            PHASE_BEGIN;
            _Pragma("unroll 1") for (int rep_ = 0; rep_ < NREP(1); ++rep_) {
            if (rep_) xcd_barrier(bar);
            {
                pg8::StaticOrder S; S.init(C::T, C::I8_N0, G, bx);
                pg8::Unit u0; S.next(0, u0); LAS float* rtab = (LAS float*)(lds + C::RTAB_OFF); build_rstd_table(P_SSQ, u0.pm, rtab, tid);
                pg8::PartOrder S8; S8.init(bx, 10);
                { LAS float* ctab = (LAS float*)(lds + C::CTAB_OFF);
                  float cv[8]; float xv = 0.f;
                  _Pragma("unroll") for (int i_ = 0; i_ < 8; ++i_) cv[i_] = (i_ < S8.cnt && tid < 256) ? WSC[C::I8_N0 + S8.tile(i_) * 256 + tid] : 0.f;
                  if (tid < 256) xv = XS[S8.pm * 256 + tid];
                  _Pragma("unroll") for (int i_ = 0; i_ < 8; ++i_) if (i_ < S8.cnt && tid < 256) ctab[i_ * 256 + tid] = cv[i_];
                  if (tid < 256) ((LAS float*)(lds + C::XTAB_OFF))[tid] = xv; }
                __syncthreads();
                int odd_ = (u0.pm >> 3) & 1; asm volatile("" : "+s"(odd_));
                _Pragma("unroll 1") for (int part_ = 0; part_ < 2; ++part_) {
                    if ((part_ ^ odd_) == 0) {
                        pg8::Gemm g{P_XB, P_WINT, C::T, C::I8_N0, C::D, C::D, C::D};
                        pg8::EpiInproj E{P_SSQ, P_ZA, P_ZB, P_ZQKV, P_ZD, P_G, rtab, u0.pm, wsp};
                        pg8::gemm_phase<pg8::EpiInproj, pg8::StaticOrder, true, true>(lds, g, S, E, wave);
                    } else {
                        pg8::Gemm g{(const bf16_t*)XQ, (const bf16_t*)(WGQ + (size_t)C::I8_N0 * C::D), C::T, C::DIN - C::I8_N0, C::D / 2, C::D / 2, C::D / 2};
                        pg8::EpiInprojI8 E{P_ZA, P_ZB, P_ZQKV, P_ZD, P_G, (const LAS float*)(lds + C::CTAB_OFF), (const LAS float*)(lds + C::XTAB_OFF), wsp, C::I8_N0 / 256, S8.l0, S8.nl, S8.h0};
                        pg8::gemm_phase<pg8::EpiInprojI8, pg8::PartOrder, true, true>(lds, g, S8, E, wave);
                    }
                }
            }
            }
            SEAM(p);
        }
        ++p;
        if (RUNS(p)) {
            PHASE_BEGIN;
            _Pragma("unroll 1") for (int rep_ = 0; rep_ < NREP(2); ++rep_) {
            if (rep_) xcd_barrier(bar);
            ph_attn(P_ZQKV, args.in[10], P_MIX, lds, vcu, G, tid, wave);
            if (NREP(20) == 2) { PHASE_BEGIN; ph_attn(P_ZQKV, args.in[10], P_MIX, lds, vcu, G, tid, wave); }
            ph_mixB(P_ZB, args.in[8] + l * 3 * 256, P_MIX, gt, ngt);
            if (NREP(21) == 2) { PHASE_BEGIN; ph_mixB(P_ZB, args.in[8] + l * 3 * 256, P_MIX, gt, ngt); }
            ph_mixD(P_ZD, P_DWT, P_MIX, lds + ATT_W_OFF + wave * ATT_WAVE_LDS, gw, ngw, lane);
            if (NREP(22) == 2) { PHASE_BEGIN; ph_mixD(P_ZD, P_DWT, P_MIX, lds + ATT_W_OFF + wave * ATT_WAVE_LDS, gw, ngw, lane); }
            ph_mixA(P_ZA, args.in[3] + l * 256, args.in[4] + l * 256, P_WSB, P_WSUM, args.in[6] + l * 4 * 128, P_MIX, lds, vcu, G, tid, wave);
            if (NREP(23) == 2) { PHASE_BEGIN; ph_mixA(P_ZA, args.in[3] + l * 256, args.in[4] + l * 256, P_WSB, P_WSUM, args.in[6] + l * 4 * 128, P_MIX, lds, vcu, G, tid, wave); }
            }
            SEAM(p);
        }
        ++p;
        if (RUNS(p)) {
            PHASE_BEGIN;
            _Pragma("unroll 1") for (int rep_ = 0; rep_ < NREP(3); ++rep_) {
            if (rep_) xcd_barrier(bar);
            pg8::gemm_merge_phase(lds, P_MIX, P_WOUTT, P_G, P_MERGED, vcu, G, wave);
            }
            SEAM(p);
        }
        ++p;
        if (RUNS(p)) {
            PHASE_BEGIN;
            pg8::Gemm g{P_MERGED, P_WOT, C::T, C::D, C::D, C::D, C::D}; pg8::StaticOrder S; S.init(C::T, C::D, G, bx);
            pg8::EpiResid E{P_XB, P_SSQ};
            pg8::gemm_phase<pg8::EpiResid, pg8::StaticOrder, false, true>(lds, g, S, E, wave);
            if (NREP(4) == 2) { xcd_barrier(bar); PHASE_BEGIN; pg8::Gemm g2{P_MERGED, P_WOT, C::T, C::D, C::D, C::D, C::D}; pg8::EpiResid E2{(bf16_t*)(wsp + 184 * C::MiB), (float*)(wsp + 216 * C::MiB)};
                pg8::gemm_phase<pg8::EpiResid, pg8::StaticOrder, false, true>(lds, g2, S, E2, wave); }
            SEAM(p);
        }
        ++p;
        if (RUNS(p)) {
            PHASE_BEGIN;
            ph_quant(P_W1T, (unsigned char*)P_W1T, (size_t)C::D * 2, WSC + 8192, 0, C::DFF, P_XB, P_SSQ, XQ, XS, true, gw, ngw, lane);
            SEAM(p);
        }
        ++p;
        if (RUNS(p)) {
            PHASE_BEGIN;
            _Pragma("unroll 1") for (int rep_ = 0; rep_ < NREP(5); ++rep_) {
            if (rep_) xcd_barrier(bar);
            pg8::Gemm g{(const bf16_t*)XQ, P_W1T, C::T, C::DFF, C::D / 2, C::D / 2, C::D}; pg8::StaticOrder S; S.init(C::T, C::DFF, G, bx);
            { LAS float* ctab = (LAS float*)(lds + C::CTAB_OFF);
              float cv[4]; int sl[4]; float xv = 0.f; pg8::Unit u0; S.next(0, u0);
              _Pragma("unroll") for (int i_ = 0; i_ < 4; ++i_) { pg8::Unit ui; const bool ok = S.next(i_, ui); sl[i_] = ok ? (ui.pn >> 2) : -1; cv[i_] = (ok && tid < 256) ? WSC[8192 + ui.pn * 256 + tid] : 0.f; }
              if (tid < 256) xv = XS[u0.pm * 256 + tid];
              _Pragma("unroll") for (int i_ = 0; i_ < 4; ++i_) if (sl[i_] >= 0 && tid < 256) ctab[sl[i_] * 256 + tid] = cv[i_];
              if (tid < 256) ((LAS float*)(lds + C::XTAB_OFF))[tid] = xv; }
            __syncthreads();
            pg8::EpiFF1I8 E{P_H, (const LAS float*)(lds + C::CTAB_OFF), (const LAS float*)(lds + C::XTAB_OFF)};
            pg8::gemm_phase<pg8::EpiFF1I8, pg8::StaticOrder, true, true>(lds, g, S, E, wave);
            }
            SEAM(p);
        }
        ++p;
        if (RUNS(p)) {
            PHASE_BEGIN;
            pg8::Gemm g{P_H, l == 0 ? P_W2T : W2T_L1, C::T, C::D, C::DFF, C::DFF, C::DFF}; pg8::StaticOrder S; S.init(C::T, C::D, G, bx);
            pg8::EpiResid E{P_XB, P_SSQ};
            pg8::gemm_phase<pg8::EpiResid, pg8::StaticOrder, false, true>(lds, g, S, E, wave);
            if (l + 1 < C::L) {
                const int l1 = l + 1;
                PHASE_BEGIN;
                ConvArgs ca{args.in[2] + (size_t)l1 * C::D * C::DIN, args.in[1] + l1 * C::D, args.in[7] + (size_t)l1 * 256 * C::D, args.in[9] + (size_t)l1 * 256 * C::D, args.in[11] + (size_t)l1 * 256 * C::D, args.in[14] + (size_t)l1 * 256 * C::D,
                            args.in[13] + l1 * 256, args.in[15] + (size_t)l1 * C::D * C::D, args.in[17] + (size_t)l1 * C::D * C::DFF, args.in[16] + l1 * C::D, args.in[18] + (size_t)l1 * C::DFF * C::D, P_WINT, P_WOUTT, P_WOT, P_W1T, W2T_L1};
                ph_convert(ca, scr, gw, ngw, lane);
                ph_convert_small(args.in[5] + (size_t)l1 * 4 * 128 * 128, args.in[12] + (size_t)l1 * 4 * 64 * 64, P_WSB, P_DWT, P_WSUM, gt, ngt);
            }
            SEAM(p);
        }
        ++p;
    }
    if (RUNS(p)) { PHASE_BEGIN; ph_final(P_XB, X, args.in[19], P_SSQ, gw, ngw, lane); }
#undef RUNS
#undef SEAM
}

extern "C" void kernel_launch(void* const* d_in, const int* in_sizes, int n_in, void* d_out, int out_size, void* d_ws, size_t ws_size, hipStream_t stream) {
    static int grid = 0;
    if (grid == 0) {
        if (n_in != 20 || out_size != C::T * C::D || ws_size < C::WS_END) { fprintf(stderr, "kernel_launch: unexpected shapes (n_in %d out %d ws %zu)\n", n_in, out_size, ws_size); grid = -1; return; }
        int dev = 0, cus = 0, per_cu = 0;
        if (hipGetDevice(&dev) != hipSuccess || hipDeviceGetAttribute(&cus, hipDeviceAttributeMultiprocessorCount, dev) != hipSuccess) { grid = -1; return; }
        if (hipFuncSetAttribute((const void*)mk_fwd, hipFuncAttributeMaxDynamicSharedMemorySize, C::LDS_BYTES) != hipSuccess) { fprintf(stderr, "kernel_launch: hipFuncSetAttribute failed\n"); grid = -1; return; }
        if (hipOccupancyMaxActiveBlocksPerMultiprocessor(&per_cu, (const void*)mk_fwd, 512, C::LDS_BYTES) != hipSuccess || per_cu < 1) { fprintf(stderr, "kernel_launch: occupancy query says %d blocks per CU\n", per_cu); grid = -1; (void)hipGetLastError(); return; }
        if (cus != 256) { fprintf(stderr, "kernel_launch: built for a 256-CU device, found %d CUs\n", cus); grid = -1; return; }
        grid = cus;
    }
    if (grid < 0) return;
    (void)hipMemsetAsync((char*)d_ws + C::WS_CTL, 0, C::CTL_ZERO_BYTES, stream);
    Args a{};
    for (int i = 0; i < 20; ++i) a.in[i] = (const float*)d_in[i];
    a.out = (float*)d_out; a.ws = (unsigned char*)d_ws;
#ifndef MK_SPLIT
    a.ph_lo = 0; a.ph_hi = NPHASES; a.li = 0;
    hipLaunchKernelGGL(mk_fwd, dim3(grid), dim3(512), C::LDS_BYTES, stream, a);
#else
    for (int p = 0; p < NPHASES; ++p) { a.ph_lo = p; a.ph_hi = p + 1; a.li = p; hipLaunchKernelGGL(mk_fwd, dim3(grid), dim3(512), C::LDS_BYTES, stream, a); }
#endif
}
```
